# Optimizing an MI355X kernel written in HIP

```python
import math
import jax, jax.numpy as jnp
from jax import lax
import numpy as np

D_MODEL = 2048
BATCH = 16
SEQ = 2048
DEPTH = 4

N_MIXERS = 3
N_NSA = (DEPTH + N_MIXERS - 1) // N_MIXERS
N_CONV = (DEPTH + N_MIXERS - 2) // N_MIXERS
N_GLA = DEPTH // N_MIXERS

DEEPNORM_ALPHA = (2.0 * DEPTH) ** 0.25
DEEPNORM_BETA = (8.0 * DEPTH) ** -0.25
LN_EPS = 1e-5
MACARON_WEIGHT = 0.5

D_FF = 5632

NSA_HEADS = 16
NSA_KV_GROUPS = 4
NSA_HEAD_DIM = D_MODEL // NSA_HEADS
NSA_Q = NSA_HEADS * NSA_HEAD_DIM
NSA_KV = NSA_KV_GROUPS * NSA_HEAD_DIM
NSA_IN = NSA_Q + 6 * NSA_KV + 3 * NSA_HEADS
CMP_BLOCK = 32
CMP_STRIDE = 16
SEL_BLOCK = 64
SEL_TOPK = 16
WINDOW = 512
SEL_Q_BLOCK = 16
ATTN_Q_BLOCK = 128
ROPE_THETA = 10000.0
MAX_POS_OFFSET = 4096
NEG = -1e30
FORCE = 1e3

CONV_WIDTH = 3

GLA_HEADS = 4
GLA_KEY_DIM = D_MODEL // 2
GLA_VAL_DIM = D_MODEL
GLA_HEAD_K = GLA_KEY_DIM // GLA_HEADS
GLA_HEAD_V = GLA_VAL_DIM // GLA_HEADS
GLA_GATE_RANK = 16
GLA_GATE_NORM = 16.0
GLA_CHUNK = 64
GLA_IN = 2 * GLA_KEY_DIM + 2 * GLA_VAL_DIM + GLA_GATE_RANK

kernel_name = "hybrid_nsa_shortconv_gla_macaron_deepnorm"


def layer_norm(x, g, b):
    xf = x.astype(jnp.float32)
    mu = jnp.mean(xf, axis=-1, keepdims=True)
    var = jnp.mean(jnp.square(xf - mu), axis=-1, keepdims=True)
    return ((xf - mu) * lax.rsqrt(var + LN_EPS) * g + b).astype(x.dtype)


def swiglu(x, w_in, w_out):
    gate, up = jnp.split(x @ w_in, 2, axis=-1)
    return (jax.nn.silu(gate) * up) @ w_out


def rope(t, positions):
    hd = t.shape[-1]
    inv = ROPE_THETA ** (-jnp.arange(0, hd, 2, dtype=jnp.float32) / hd)
    ang = positions.astype(jnp.float32)[..., None] * inv
    cos = jnp.cos(ang)[:, :, None, :]
    sin = jnp.sin(ang)[:, :, None, :]
    t1, t2 = jnp.split(t.astype(jnp.float32), 2, axis=-1)
    return jnp.concatenate([t1 * cos - t2 * sin, t2 * cos + t1 * sin], axis=-1).astype(t.dtype)


def masked_softmax(s, valid):
    p = jax.nn.softmax(jnp.where(valid, s.astype(jnp.float32), NEG), axis=-1)
    return jnp.where(valid, p, 0.0)


def nsa_mixer(x, positions, w_in, gate_b, cmp_pos, cmp_w1, cmp_w2, w_out):
    B, T, _ = x.shape
    H, G, hd = NSA_HEADS, NSA_KV_GROUPS, NSA_HEAD_DIM
    R = H // G
    scale = hd ** -0.5
    splits = [NSA_Q + i * NSA_KV for i in range(7)]
    q, kc, vc, ks, vs, kw, vw, gl = jnp.split(x @ w_in, splits, axis=-1)
    q = rope(q.reshape(B, T, H, hd), positions)
    kc, ks, kw = [rope(t.reshape(B, T, G, hd), positions) for t in (kc, ks, kw)]
    vc, vs, vw = [t.reshape(B, T, G, hd) for t in (vc, vs, vw)]
    gates = jax.nn.sigmoid(gl + gate_b).reshape(B, T, 3, G, R).transpose(2, 0, 3, 4, 1)
    qg = q.reshape(B, T, G, R, hd).transpose(0, 2, 3, 1, 4) * scale
    tq = jnp.arange(T)

    n_cmp = (T - CMP_BLOCK) // CMP_STRIDE + 1
    tok = np.arange(n_cmp)[:, None] * CMP_STRIDE + np.arange(CMP_BLOCK)[None, :]

    def compress(t, pos_emb, w1, w2):
        blocks = t[:, tok] + pos_emb[:, None, :]
        blocks = blocks.transpose(0, 1, 3, 2, 4).reshape(B, n_cmp, G, CMP_BLOCK * hd)
        return jax.nn.gelu(blocks @ w1) @ w2

    k_cmp = compress(kc, cmp_pos[0], cmp_w1[0], cmp_w2[0])
    v_cmp = compress(vc, cmp_pos[1], cmp_w1[1], cmp_w2[1])
    cmp_end = jnp.arange(n_cmp) * CMP_STRIDE + CMP_BLOCK - 1
    s_cmp = jnp.einsum('bgrtd,bngd->bgrtn', qg, k_cmp)
    p_cmp = masked_softmax(s_cmp, cmp_end[None, :] <= tq[:, None])
    o_cmp = jnp.einsum('bgrtn,bngd->bgrtd', p_cmp.astype(v_cmp.dtype), v_cmp)

    n_sel = T // SEL_BLOCK
    k_sel = min(SEL_TOPK, n_sel)
    c_start = jnp.arange(n_cmp) * CMP_STRIDE
    s_start = jnp.arange(n_sel) * SEL_BLOCK
    overlap = ((c_start[:, None] < s_start[None, :] + SEL_BLOCK)
               & (c_start[:, None] + CMP_BLOCK > s_start[None, :])).astype(jnp.float32)
    importance = jnp.einsum('bgrtn,nm->bgtm', p_cmp, overlap)
    cur = tq // SEL_BLOCK
    blk = jnp.arange(n_sel)
    sel_valid = blk[None, :] <= cur[:, None]
    forced = (blk[None, :] == 0) | (blk[None, :] == cur[:, None]) | (blk[None, :] == cur[:, None] - 1)
    score = jnp.where(sel_valid, importance + jnp.where(forced, FORCE, 0.0), NEG)
    _, idx = lax.top_k(score, k_sel)
    ks_blk = ks.reshape(B, n_sel, SEL_BLOCK, G, hd).transpose(0, 3, 1, 2, 4)
    vs_blk = vs.reshape(B, n_sel, SEL_BLOCK, G, hd).transpose(0, 3, 1, 2, 4)
    bi = jnp.arange(B)[:, None, None, None]
    gi = jnp.arange(G)[None, :, None, None]

    def sel_block(c):
        t0 = c * SEL_Q_BLOCK
        qc = lax.dynamic_slice_in_dim(qg, t0, SEL_Q_BLOCK, axis=3)
        ic = lax.dynamic_slice_in_dim(idx, t0, SEL_Q_BLOCK, axis=2)
        kg = ks_blk[bi, gi, ic]
        vg = vs_blk[bi, gi, ic]
        s = jnp.einsum('bgrqd,bgqkld->bgrqkl', qc, kg).reshape(B, G, R, SEL_Q_BLOCK, k_sel * SEL_BLOCK)
        kpos = ic[..., None] * SEL_BLOCK + jnp.arange(SEL_BLOCK)
        qpos = t0 + jnp.arange(SEL_Q_BLOCK)
        valid = (kpos <= qpos[None, None, :, None, None]).reshape(B, G, 1, SEL_Q_BLOCK, k_sel * SEL_BLOCK)
        p = masked_softmax(s, valid).astype(vg.dtype).reshape(B, G, R, SEL_Q_BLOCK, k_sel, SEL_BLOCK)
        return jnp.einsum('bgrqkl,bgqkld->bgrqd', p, vg)

    o_sel = lax.map(sel_block, jnp.arange(T // SEL_Q_BLOCK))
    o_sel = o_sel.transpose(1, 2, 3, 0, 4, 5).reshape(B, G, R, T, hd)

    pad = ((0, 0), (0, 0), (WINDOW, 0), (0, 0))
    kw_p = jnp.pad(kw.transpose(0, 2, 1, 3), pad)
    vw_p = jnp.pad(vw.transpose(0, 2, 1, 3), pad)
    band = WINDOW + ATTN_Q_BLOCK

    def win_block(c):
        t0 = c * ATTN_Q_BLOCK
        qb = lax.dynamic_slice_in_dim(qg, t0, ATTN_Q_BLOCK, axis=3)
        kb = lax.dynamic_slice_in_dim(kw_p, t0, band, axis=2)
        vb = lax.dynamic_slice_in_dim(vw_p, t0, band, axis=2)
        s = jnp.einsum('bgrqd,bgkd->bgrqk', qb, kb)
        kpos = t0 - WINDOW + jnp.arange(band)
        qpos = t0 + jnp.arange(ATTN_Q_BLOCK)
        valid = ((kpos[None, :] <= qpos[:, None]) & (kpos[None, :] > qpos[:, None] - WINDOW)
                 & (kpos[None, :] >= 0))
        p = masked_softmax(s, valid).astype(vb.dtype)
        return jnp.einsum('bgrqk,bgkd->bgrqd', p, vb)

    o_win = lax.map(win_block, jnp.arange(T // ATTN_Q_BLOCK))
    o_win = o_win.transpose(1, 2, 3, 0, 4, 5).reshape(B, G, R, T, hd)

    o = gates[0][..., None] * o_cmp + gates[1][..., None] * o_sel + gates[2][..., None] * o_win
    o = o.transpose(0, 3, 1, 2, 4).reshape(B, T, H * hd)
    return o @ w_out


def conv_mixer(x, w_in, conv_w, w_out):
    D = x.shape[-1]
    b_gate, c_gate, h = jnp.split(x @ w_in, 3, axis=-1)
    u = c_gate * h
    y = lax.conv_general_dilated(u, conv_w[:, None, :], window_strides=(1,),
                                 padding=[(CONV_WIDTH - 1, 0)],
                                 dimension_numbers=('NWC', 'WIO', 'NWC'),
                                 feature_group_count=D)
    return (b_gate * y) @ w_out


def gla_chunked(q, k, v, g):
    B, T, H, dk = q.shape
    dv = v.shape[-1]
    C = GLA_CHUNK
    N = T // C

    def chunks(t):
        return t.reshape(B, N, C, H, t.shape[-1]).transpose(1, 0, 3, 2, 4)

    q, k, v, g = chunks(q), chunks(k), chunks(v), chunks(g)
    b = jnp.cumsum(g, axis=3)
    b_last = b[..., -1:, :]
    qd = q * jnp.exp(b)
    kd = k * jnp.exp(-b)
    kl = k * jnp.exp(b_last - b)
    causal = jnp.tril(jnp.ones((C, C), dtype=bool))
    a = jnp.where(causal, jnp.einsum('nbhcd,nbhsd->nbhcs', qd, kd), 0.0)
    o_intra = jnp.einsum('nbhcs,nbhsv->nbhcv', a, v)
    decay = jnp.exp(b_last[..., 0, :])

    def step(state, inp):
        qd_n, kl_n, v_n, dl_n = inp
        o_n = jnp.einsum('bhcd,bhdv->bhcv', qd_n, state)
        state = state * dl_n[..., None] + jnp.einsum('bhcd,bhcv->bhdv', kl_n, v_n)
        return state, o_n

    s0 = jnp.zeros((B, H, dk, dv), q.dtype)
    _, o_inter = lax.scan(step, s0, (qd, kl, v, decay))
    return (o_intra + o_inter).transpose(1, 0, 3, 2, 4).reshape(B, T, H, dv)


def gla_mixer(x, w_in, w_a2, b_a, norm_g, w_out):
    B, T, _ = x.shape
    splits = [GLA_KEY_DIM, 2 * GLA_KEY_DIM, 2 * GLA_KEY_DIM + GLA_VAL_DIM, 2 * GLA_KEY_DIM + 2 * GLA_VAL_DIM]
    q, k, v, r, a = jnp.split(x @ w_in, splits, axis=-1)
    gk = jax.nn.log_sigmoid((a @ w_a2 + b_a).astype(jnp.float32)) / GLA_GATE_NORM
    f32 = jnp.float32
    q = q.astype(f32).reshape(B, T, GLA_HEADS, GLA_HEAD_K) * (GLA_HEAD_K ** -0.5)
    k = k.astype(f32).reshape(B, T, GLA_HEADS, GLA_HEAD_K)
    v = v.astype(f32).reshape(B, T, GLA_HEADS, GLA_HEAD_V)
    gk = gk.reshape(B, T, GLA_HEADS, GLA_HEAD_K)
    o = gla_chunked(q, k, v, gk)
    o = o * lax.rsqrt(jnp.mean(jnp.square(o), axis=-1, keepdims=True) + LN_EPS) * norm_g
    o = o.astype(x.dtype).reshape(B, T, GLA_VAL_DIM) * jax.nn.silu(r)
    return o @ w_out


def setup_inputs(seed: int = 0) -> dict:
    key = jax.random.key(seed)
    ks = jax.random.split(key, 20)

    def nrm(k, shape, scale):
        return jax.random.normal(k, shape, jnp.float32) * scale

    D = D_MODEL
    hd = NSA_HEAD_DIM
    x = nrm(ks[0], (BATCH, SEQ, D), 1.0)
    positions = (jax.random.randint(ks[1], (BATCH, 1), 0, MAX_POS_OFFSET, dtype=jnp.int32)
                 + jnp.arange(SEQ, dtype=jnp.int32)[None, :])
    return {
        'x': x,
        'positions': positions,
        'ln_g': 1.0 + nrm(ks[2], (DEPTH, 3, D), 0.02),
        'ln_b': nrm(ks[3], (DEPTH, 3, D), 0.02),
        'ffn_w_in': nrm(ks[4], (DEPTH, 2, D, 2 * D_FF), D ** -0.5),
        'ffn_w_out': nrm(ks[5], (DEPTH, 2, D_FF, D), D_FF ** -0.5 * DEEPNORM_BETA),
        'nsa_w_in': nrm(ks[6], (N_NSA, D, NSA_IN), D ** -0.5),
        'nsa_gate_b': nrm(ks[7], (N_NSA, 3 * NSA_HEADS), 0.1),
        'nsa_cmp_pos': nrm(ks[8], (N_NSA, 2, CMP_BLOCK, hd), 0.1),
        'nsa_cmp_w1': nrm(ks[9], (N_NSA, 2, CMP_BLOCK * hd, hd), (CMP_BLOCK * hd) ** -0.5),
        'nsa_cmp_w2': nrm(ks[10], (N_NSA, 2, hd, hd), hd ** -0.5),
        'nsa_w_out': nrm(ks[11], (N_NSA, NSA_Q, D), NSA_Q ** -0.5 * DEEPNORM_BETA),
        'conv_w_in': nrm(ks[12], (N_CONV, D, 3 * D), D ** -0.5),
        'conv_w': nrm(ks[13], (N_CONV, CONV_WIDTH, D), CONV_WIDTH ** -0.5),
        'conv_w_out': nrm(ks[14], (N_CONV, D, D), D ** -0.5 * DEEPNORM_BETA),
        'gla_w_in': nrm(ks[15], (N_GLA, D, GLA_IN), D ** -0.5),
        'gla_w_a2': nrm(ks[16], (N_GLA, GLA_GATE_RANK, GLA_KEY_DIM), GLA_GATE_RANK ** -0.5),
        'gla_b_a': nrm(ks[17], (N_GLA, GLA_KEY_DIM), 0.1),
        'gla_norm_g': 1.0 + nrm(ks[18], (N_GLA, GLA_HEAD_V), 0.02),
        'gla_w_out': nrm(ks[19], (N_GLA, GLA_VAL_DIM, D), GLA_VAL_DIM ** -0.5 * DEEPNORM_BETA),
    }


def reference(x, positions, ln_g, ln_b, ffn_w_in, ffn_w_out,
              nsa_w_in, nsa_gate_b, nsa_cmp_pos, nsa_cmp_w1, nsa_cmp_w2, nsa_w_out,
              conv_w_in, conv_w, conv_w_out,
              gla_w_in, gla_w_a2, gla_b_a, gla_norm_g, gla_w_out):
    for i in range(DEPTH):
        x = layer_norm(DEEPNORM_ALPHA * x + MACARON_WEIGHT * swiglu(x, ffn_w_in[i, 0], ffn_w_out[i, 0]),
                       ln_g[i, 0], ln_b[i, 0])
        kind, j = i % N_MIXERS, i // N_MIXERS
        if kind == 0:
            y = nsa_mixer(x, positions, nsa_w_in[j], nsa_gate_b[j], nsa_cmp_pos[j],
                          nsa_cmp_w1[j], nsa_cmp_w2[j], nsa_w_out[j])
        elif kind == 1:
            y = conv_mixer(x, conv_w_in[j], conv_w[j], conv_w_out[j])
        else:
            y = gla_mixer(x, gla_w_in[j], gla_w_a2[j], gla_b_a[j], gla_norm_g[j], gla_w_out[j])
        x = layer_norm(DEEPNORM_ALPHA * x + y, ln_g[i, 1], ln_b[i, 1])
        x = layer_norm(DEEPNORM_ALPHA * x + MACARON_WEIGHT * swiglu(x, ffn_w_in[i, 1], ffn_w_out[i, 1]),
                       ln_g[i, 2], ln_b[i, 2])
    return x
```

```cpp
#include <hip/hip_runtime.h>
#include <cstdio>
#include <cstdint>
constexpr size_t MiB = 1u << 20;
constexpr size_t MX_CONV_BG = 0, MX_CONV_U = 128 * MiB;
constexpr size_t MX_GLA_Q = 0, MX_GLA_K = 64 * MiB, MX_GLA_VT = 128 * MiB, MX_GLA_R = 256 * MiB, MX_GLA_KLT = 384 * MiB, MX_GLA_O = 448 * MiB,
                 MX_GLA_A = 576 * MiB, MX_GLA_DEC = 578 * MiB, MX_GLA_SSQ = 580 * MiB;
constexpr size_t MX_NSA_Q = 0, MX_NSA_KC = 128 * MiB, MX_NSA_VC = 160 * MiB, MX_NSA_KS = 192 * MiB, MX_NSA_VST = 224 * MiB, MX_NSA_KW = 256 * MiB, MX_NSA_VWT = 288 * MiB,
                 MX_NSA_GT = 320 * MiB, MX_NSA_KCMP = 328 * MiB, MX_NSA_VCMPT = 330 * MiB;
namespace pg8 {
#define PG8_LAS __attribute__((address_space(3)))
constexpr int WIDTAB_BYTE = 144896 + 1024;
__device__ __forceinline__ unsigned hw_wave_slot() { return (unsigned)__builtin_amdgcn_s_getreg((5 << 11) | 4) & 63u; }
__device__ __forceinline__ int wave_idx(const PG8_LAS unsigned char* lds0) { return __builtin_amdgcn_readfirstlane(*(const volatile PG8_LAS int*)(lds0 + WIDTAB_BYTE + hw_wave_slot() * 4)); }
__device__ __forceinline__ int lane_idx() { unsigned z = 0u; asm volatile("" : "+v"(z)); return (int)__builtin_amdgcn_mbcnt_hi(~0u, __builtin_amdgcn_mbcnt_lo(~0u, z)); }
__device__ __forceinline__ int tidx(const PG8_LAS unsigned char* lds0) { return wave_idx(lds0) * 64 + lane_idx(); }
typedef unsigned short bf16_t;
typedef short bf16x8 __attribute__((ext_vector_type(8)));
typedef float f32x4 __attribute__((ext_vector_type(4)));
typedef unsigned u32x4 __attribute__((ext_vector_type(4)));
constexpr int BM = 256, BK = 64, HALF = 128, HTB = HALF * BK * 2  , STAGE_BYTES = 8 * HTB, NXCD = 8, WGM = 8;

__host__ __device__ __forceinline__ int lds_byte(int r, int c) { const int st = (r >> 4) * 2 + (c >> 5), rr = r & 15, cc = c & 31, ob = rr * 64 + cc * 2; return st * 1024 + (ob ^ (((ob >> 9) & 1) << 5)); }
__host__ __device__ __forceinline__ void stage_rc(int b, int& R, int& C) { const int st = b / 1024, sb = b % 1024, swz = sb ^ (((sb >> 9) & 1) << 5); R = (st >> 1) * 16 + swz / 64; C = (st & 1) * 32 + (swz % 64) / 2; }
__host__ __device__ __forceinline__ int perm32(int rho) { const int n = rho >> 4, i = rho & 15; return 8 * (i >> 2) + 4 * n + (i & 3); }

struct Unit { int pm, pn, par; };
struct Gemm { const bf16_t* A; const bf16_t* Bt; int M, N, K; };

struct StaticOrder {
    int nM, nN, nwg, G, c, wgm;
    __host__ __device__ void init(int M, int N, int G_, int c_, int wgm_ = WGM) { nM = M / BM; nN = N / BM; nwg = nM * nN; G = G_; c = c_; wgm = wgm_; }
    __host__ __device__ bool next(int i, Unit& u) const {
        const long L = (long)i * G + c; if (L >= nwg) return false;
        int wgid = (int)L; { const int q = nwg / NXCD, r = nwg % NXCD, xcd = wgid % NXCD, off = wgid / NXCD; wgid = (xcd < r ? xcd * (q + 1) : r * (q + 1) + (xcd - r) * q) + off; }
        const int nig = wgm * nN, gid = wgid / nig, fm = gid * wgm, gsz = (nM - fm) < wgm ? (nM - fm) : wgm;
        u.pm = fm + ((wgid % nig) % gsz); u.pn = (wgid % nig) / gsz; u.par = i & 1; return true;
    }
    __device__ __forceinline__ void a_ready(const Unit&) const {}
    __device__ __forceinline__ void done(const Unit&) const {}
};
typedef float f32x2_t __attribute__((ext_vector_type(2))); typedef __bf16 bf16x2_t __attribute__((ext_vector_type(2)));
__device__ __forceinline__ unsigned cvt_pk_bf16(float lo, float hi) { f32x2_t v = {lo, hi}; bf16x2_t b = __builtin_convertvector(v, bf16x2_t); return __builtin_bit_cast(unsigned, b); }
typedef float f32x2 __attribute__((ext_vector_type(2)));
typedef _Float16 f16x2_t __attribute__((ext_vector_type(2))); typedef _Float16 f16x8_t __attribute__((ext_vector_type(8)));
__device__ __forceinline__ unsigned cvt_pk_f16(float lo, float hi) { f32x2_t v = {lo, hi}; f16x2_t b = __builtin_convertvector(v, f16x2_t); return __builtin_bit_cast(unsigned, b); }
__device__ __forceinline__ f32x2_t unpk_f16(unsigned w) { return __builtin_convertvector(__builtin_bit_cast(f16x2_t, w), f32x2_t); }
template <bool F16> __device__ __forceinline__ f32x4 mma_sel(const bf16x8& a, const bf16x8& b, const f32x4& c) {
    if constexpr (F16) return __builtin_amdgcn_mfma_f32_16x16x32_f16(__builtin_bit_cast(f16x8_t, a), __builtin_bit_cast(f16x8_t, b), c, 0, 0, 0);
    else return __builtin_amdgcn_mfma_f32_16x16x32_bf16(a, b, c, 0, 0, 0);
}
typedef unsigned u32x2 __attribute__((ext_vector_type(2)));
__device__ __forceinline__ float silu_f(float x) { return x * __builtin_amdgcn_rcpf(1.0f + __expf(-x)); }
__device__ __forceinline__ float sigmoid_f(float x) { return __builtin_amdgcn_rcpf(1.0f + __expf(-x)); }
__device__ __forceinline__ u32x4 pack8(const f32x4 a, const f32x4 b) { u32x4 w; w.x = cvt_pk_bf16(a[0], a[1]); w.y = cvt_pk_bf16(a[2], a[3]); w.z = cvt_pk_bf16(b[0], b[1]); w.w = cvt_pk_bf16(b[2], b[3]); return w; }
__device__ __forceinline__ unsigned short bf16_1(float x) { return (unsigned short)(cvt_pk_bf16(x, 0.f) & 0xffffu); }

constexpr int STAT_TAB_OFF = 131072;
struct LnFix { const float* cs; const float* bv; const float* rs; PG8_LAS unsigned char* aux; };
template <bool PERM>
__device__ __forceinline__ void apply_lnfix(const LnFix& F, f32x4 (&acc)[2][2][4][2], const Unit& u, int wr, int wc, int fr, int fq) {
    asm volatile("" : "+v"(fr), "+v"(fq));
    f32x2 st[2][4];
#pragma unroll
    for (int ai = 0; ai < 2; ++ai)
#pragma unroll
        for (int m = 0; m < 4; ++m) st[ai][m] = *(const PG8_LAS f32x2*)(F.aux + (ai * HALF + wr * 64 + m * 16 + fr) * 8);
#pragma unroll
    for (int bj = 0; bj < 2; ++bj)
#pragma unroll
        for (int n = 0; n < 2; ++n) { const int c = bj * HALF + wc * 32 + (PERM ? 8 * fq + 4 * n : 16 * n + 4 * fq);
            const f32x4 cs = *(const PG8_LAS f32x4*)(F.aux + 2048 + c * 4), bv = *(const PG8_LAS f32x4*)(F.aux + 3072 + c * 4);
#pragma unroll
            for (int ai = 0; ai < 2; ++ai)
#pragma unroll
                for (int m = 0; m < 4; ++m) acc[ai][bj][m][n] = (acc[ai][bj][m][n] - cs * st[ai][m].x) * st[ai][m].y + bv; }
}
__device__ __forceinline__ void stage_lnfix(const LnFix& F, const Unit& u, int tid, int wid) {
    asm volatile("" : "+v"(tid));
    const char* b0 = (const char*)(F.rs + (size_t)u.pm * (2 * BM)); const char* b1 = (const char*)((wid < 4 ? F.cs : F.bv) + u.pn * BM);
    const unsigned o0 = (unsigned)tid * 4u, o1 = (unsigned)(tid & 255) * 4u;
    __builtin_amdgcn_global_load_lds((const unsigned*)(b0 + o0), (PG8_LAS unsigned*)(F.aux + wid * 256), 4, 0, 0);
    __builtin_amdgcn_global_load_lds((const unsigned*)(b1 + o1), (PG8_LAS unsigned*)(F.aux + 2048 + wid * 256), 4, 0, 0);
}
#define LNFIX_TOP() do { apply_lnfix<PERM>(fix, const_cast<f32x4 (&)[2][2][4][2]>(acc), u, wr, wc, fr, fq); } while (0)
struct EpiSwiglu {
    static constexpr bool PERM = true, AFTER_DRAIN = false;
    bf16_t* H; int ldh; LnFix fix;
    __device__ __forceinline__ void operator()(const f32x4 (&acc)[2][2][4][2], const Unit& u, int wr, int wc, int fr, int fq) const {
        LNFIX_TOP();
        const int row0 = u.pm * BM + wr * 64 + fr, col0 = u.pn * HALF + wc * 32 + 8 * fq;
#pragma unroll
        for (int ai = 0; ai < 2; ++ai)
#pragma unroll
            for (int m = 0; m < 4; ++m) { bf16_t* rowp = H + (size_t)(row0 + ai * HALF + m * 16) * ldh + col0;
                f32x4 h0, h1;
#pragma unroll
                for (int e = 0; e < 4; ++e) { h0[e] = silu_f(acc[ai][0][m][0][e]) * acc[ai][1][m][0][e]; h1[e] = silu_f(acc[ai][0][m][1][e]) * acc[ai][1][m][1][e]; }
                *(u32x4*)rowp = pack8(h0, h1); }
    }
};
struct EpiResid {
    static constexpr bool PERM = true, AFTER_DRAIN = false;
    float* out; bf16_t* zb; float* ps; float scale; const float* g; const float* b; const float* rs; PG8_LAS unsigned char* aux;
    static constexpr float alpha = 1.6817928305074292f; static constexpr int ld = 2048;
    __device__ __forceinline__ void operator()(const f32x4 (&acc)[2][2][4][2], const Unit& u, int wr, int wc, int fr, int fq) const {
        asm volatile("" : "+v"(fr), "+v"(fq));
        float sc = scale; asm volatile("" : "+v"(sc));
        const int row0 = u.pm * BM + wr * 64 + fr, col0 = u.pn * BM + wc * 32 + 8 * fq;
        unsigned char* zbase = (unsigned char*)(zb + (size_t)u.pm * BM * ld + u.pn * BM);
        const unsigned zo = (unsigned)(((wr * 64 + fr) * ld + wc * 32 + 8 * fq) * 2);
        f32x2 sta[2][4];
#pragma unroll
        for (int ai = 0; ai < 2; ++ai)
#pragma unroll
            for (int m = 0; m < 4; ++m) sta[ai][m] = *(const PG8_LAS f32x2*)(aux + (ai * HALF + wr * 64 + m * 16 + fr) * 8);
#pragma unroll
        for (int ai = 0; ai < 2; ++ai) {
            f32x2 st[4]; float rsum[4], rsq[4];
#pragma unroll
            for (int m = 0; m < 4; ++m) { rsum[m] = 0.f; rsq[m] = 0.f; }
#pragma unroll
            for (int bj = 0; bj < 2; ++bj) { const int c = col0 + bj * HALF;
                const int cl = (bj * HALF + wc * 32 + 8 * fq) * 4;
                const f32x4 g0 = *(const PG8_LAS f32x4*)(aux + 2048 + cl), g1 = *(const PG8_LAS f32x4*)(aux + 2048 + cl + 16), b0 = *(const PG8_LAS f32x4*)(aux + 3072 + cl) * alpha, b1 = *(const PG8_LAS f32x4*)(aux + 3072 + cl + 16) * alpha;
                u32x4 xw[4];
#pragma unroll
                for (int m = 0; m < 4; ++m) xw[m] = *(const u32x4*)(zbase + (zo + (unsigned)(((ai * HALF + m * 16) * ld + bj * HALF) * 2)));
                if (bj == 0) {
#pragma unroll
                    for (int m = 0; m < 4; ++m) { st[m] = sta[ai][m]; st[m].y *= alpha; st[m].x *= -st[m].y; } }
#pragma unroll
                for (int m = 0; m < 4; ++m) { const unsigned off = zo + (unsigned)(((ai * HALF + m * 16) * ld + bj * HALF) * 2);
                    const unsigned wx = xw[m].x, wy = xw[m].y, wz = xw[m].z, ww = xw[m].w;
                    const f16x2_t q0 = __builtin_bit_cast(f16x2_t, wx), q1 = __builtin_bit_cast(f16x2_t, wy), q2 = __builtin_bit_cast(f16x2_t, wz), q3 = __builtin_bit_cast(f16x2_t, ww);
                    const float ra = st[m].y, nm = st[m].x;
                    const f32x4 t0 = (f32x4){__builtin_fmaf((float)q0[0], ra, nm), __builtin_fmaf((float)q0[1], ra, nm), __builtin_fmaf((float)q1[0], ra, nm), __builtin_fmaf((float)q1[1], ra, nm)};
                    const f32x4 t1 = (f32x4){__builtin_fmaf((float)q2[0], ra, nm), __builtin_fmaf((float)q2[1], ra, nm), __builtin_fmaf((float)q3[0], ra, nm), __builtin_fmaf((float)q3[1], ra, nm)};
                    const f32x4 z0 = g0 * t0 + (acc[ai][bj][m][0] * sc + b0), z1 = g1 * t1 + (acc[ai][bj][m][1] * sc + b1);
                    { u32x4 w; w.x = cvt_pk_f16(z0[0], z0[1]); w.y = cvt_pk_f16(z0[2], z0[3]); w.z = cvt_pk_f16(z1[0], z1[1]); w.w = cvt_pk_f16(z1[2], z1[3]); *(u32x4*)(zbase + off) = w; }
                    rsum[m] += ((z0[0] + z0[1]) + (z0[2] + z0[3])) + ((z1[0] + z1[1]) + (z1[2] + z1[3]));
                    rsq[m] += ((z0[0] * z0[0] + z0[1] * z0[1]) + (z0[2] * z0[2] + z0[3] * z0[3])) + ((z1[0] * z1[0] + z1[1] * z1[1]) + (z1[2] * z1[2] + z1[3] * z1[3])); }
                asm volatile("" ::: "memory"); }
#pragma unroll
            for (int m = 0; m < 4; ++m) { float a = rsum[m], q = rsq[m]; a += __shfl_xor(a, 16); q += __shfl_xor(q, 16); a += __shfl_xor(a, 32); q += __shfl_xor(q, 32);
                if (fq == 0) *(f32x2*)(ps + ((size_t)(row0 + ai * HALF + m * 16) * 32 + u.pn * 4 + wc) * 2) = (f32x2){a, q}; }
        }
    }
};
struct EpiConvIn {
    static constexpr bool PERM = true, AFTER_DRAIN = false;
    bf16_t* BG; bf16_t* U; LnFix fix;
    __device__ __forceinline__ void operator()(const f32x4 (&acc)[2][2][4][2], const Unit& u, int wr, int wc, int fr, int fq) const {
        LNFIX_TOP();
        const int row0 = u.pm * BM + wr * 64 + fr;
        if (u.pn < 8) {
            const int col0 = u.pn * BM + wc * 32 + 8 * fq;
#pragma unroll
            for (int ai = 0; ai < 2; ++ai)
#pragma unroll
                for (int m = 0; m < 4; ++m) { bf16_t* rowp = BG + (size_t)(row0 + ai * HALF + m * 16) * 2048 + col0;
#pragma unroll
                    for (int bj = 0; bj < 2; ++bj) *(u32x4*)(rowp + bj * HALF) = pack8(acc[ai][bj][m][0], acc[ai][bj][m][1]); }
        } else {
            const int col0 = (u.pn - 8) * HALF + wc * 32 + 8 * fq;
#pragma unroll
            for (int ai = 0; ai < 2; ++ai)
#pragma unroll
                for (int m = 0; m < 4; ++m) { bf16_t* rowp = U + (size_t)(row0 + ai * HALF + m * 16) * 2048 + col0;
                    *(u32x4*)rowp = pack8(acc[ai][0][m][0] * acc[ai][1][m][0], acc[ai][0][m][1] * acc[ai][1][m][1]); }
        }
    }
};
struct EpiGlaIn {
    static constexpr bool PERM = true, AFTER_DRAIN = false;
    unsigned char* mix; LnFix fix;
    __device__ __forceinline__ void operator()(const f32x4 (&acc)[2][2][4][2], const Unit& u, int wr, int wc, int fr, int fq) const {
        LNFIX_TOP();
        const int row0 = u.pm * BM + wr * 64 + fr;
        bf16_t* const VT = (bf16_t*)(mix + MX_GLA_VT); bf16_t* const R = (bf16_t*)(mix + MX_GLA_R); float* const A = (float*)(mix + MX_GLA_A);
        if (u.pn < 8) {
            bf16_t* base = (bf16_t*)(mix + (u.pn < 4 ? MX_GLA_Q : MX_GLA_K)); const float sc = u.pn < 4 ? 0.0625f : 1.0f; const int col0 = (u.pn & 3) * BM + wc * 32 + 8 * fq;
#pragma unroll
            for (int ai = 0; ai < 2; ++ai)
#pragma unroll
                for (int m = 0; m < 4; ++m) { bf16_t* rowp = base + (size_t)(row0 + ai * HALF + m * 16) * 1024 + col0;
#pragma unroll
                    for (int bj = 0; bj < 2; ++bj) *(u32x4*)(rowp + bj * HALF) = pack8(acc[ai][bj][m][0] * sc, acc[ai][bj][m][1] * sc); }
        } else if (u.pn < 16) {
            const int col0 = (u.pn - 8) * BM + wc * 32 + 8 * fq;
#pragma unroll
            for (int ai = 0; ai < 2; ++ai)
#pragma unroll
                for (int m = 0; m < 4; ++m) { const int row = row0 + ai * HALF + m * 16, b = row >> 11, t = row & 2047;
                    bf16_t* p = VT + ((size_t)b * 2048 + col0) * 2048 + t;
#pragma unroll
                    for (int bj = 0; bj < 2; ++bj)
#pragma unroll
                        for (int n = 0; n < 2; ++n)
#pragma unroll
                            for (int e = 0; e < 4; ++e) p[(size_t)(bj * HALF + 4 * n + e) * 2048] = bf16_1(acc[ai][bj][m][n][e]); }
        } else if (u.pn < 24) {
            const int col0 = (u.pn - 16) * BM + wc * 32 + 8 * fq;
#pragma unroll
            for (int ai = 0; ai < 2; ++ai)
#pragma unroll
                for (int m = 0; m < 4; ++m) { bf16_t* rowp = R + (size_t)(row0 + ai * HALF + m * 16) * 2048 + col0;
#pragma unroll
                    for (int bj = 0; bj < 2; ++bj) { f32x4 s0, s1;
#pragma unroll
                        for (int e = 0; e < 4; ++e) { s0[e] = silu_f(acc[ai][bj][m][0][e]); s1[e] = silu_f(acc[ai][bj][m][1][e]); }
                        *(u32x4*)(rowp + bj * HALF) = pack8(s0, s1); } }
        } else {
            if (wc == 0 && fq < 2) {
#pragma unroll
                for (int ai = 0; ai < 2; ++ai)
#pragma unroll
                    for (int m = 0; m < 4; ++m) { float* rowp = A + (size_t)(row0 + ai * HALF + m * 16) * 16 + 8 * fq;
                        *(f32x4*)rowp = acc[ai][0][m][0]; *(f32x4*)(rowp + 4) = acc[ai][0][m][1]; }
            }
        }
    }
};
struct EpiNsaIn {
    static constexpr bool PERM = true, AFTER_DRAIN = false;
    unsigned char* mix; const float* cosT; const float* sinT; const float* gate_b; float qscale; LnFix fix;
    __device__ __forceinline__ void operator()(const f32x4 (&acc)[2][2][4][2], const Unit& u, int wr, int wc, int fr, int fq) const {
        LNFIX_TOP();
        const int row0 = u.pm * BM + wr * 64 + fr; const int pn = u.pn;
        const bool rope = pn < 10 || pn == 12 || pn == 13 || pn == 16 || pn == 17;
        if (rope) {
            bf16_t* base; int ld, tc0; float sc = 1.0f;
            if (pn < 8) { base = (bf16_t*)(mix + MX_NSA_Q); ld = 2048; tc0 = pn * 256; sc = qscale; }
            else { base = (bf16_t*)(mix + (pn < 10 ? MX_NSA_KC : (pn < 14 ? MX_NSA_KS : MX_NSA_KW))); ld = 512; tc0 = (pn & 1) * 256; }
            const int dd0 = 32 * (wc & 1) + 8 * fq, oc0 = tc0 + (wc >> 1) * 128 + dd0;
#pragma unroll
            for (int ai = 0; ai < 2; ++ai)
#pragma unroll
                for (int m = 0; m < 4; ++m) { const int row = row0 + ai * HALF + m * 16;
                    const f32x4 c0 = *(const f32x4*)(cosT + (size_t)row * 64 + dd0), c1 = *(const f32x4*)(cosT + (size_t)row * 64 + dd0 + 4);
                    const f32x4 s0 = *(const f32x4*)(sinT + (size_t)row * 64 + dd0), s1 = *(const f32x4*)(sinT + (size_t)row * 64 + dd0 + 4);
                    const f32x4 a0 = acc[ai][0][m][0], a1 = acc[ai][0][m][1], b0 = acc[ai][1][m][0], b1 = acc[ai][1][m][1];
                    bf16_t* rowp = base + (size_t)row * ld + oc0;
                    *(u32x4*)rowp = pack8((a0 * c0 - b0 * s0) * sc, (a1 * c1 - b1 * s1) * sc);
                    *(u32x4*)(rowp + 64) = pack8((b0 * c0 + a0 * s0) * sc, (b1 * c1 + a1 * s1) * sc); }
        } else if (pn == 10 || pn == 11) {
            const int col0 = (pn & 1) * BM + wc * 32 + 8 * fq;
#pragma unroll
            for (int ai = 0; ai < 2; ++ai)
#pragma unroll
                for (int m = 0; m < 4; ++m) { bf16_t* rowp = (bf16_t*)(mix + MX_NSA_VC) + (size_t)(row0 + ai * HALF + m * 16) * 512 + col0;
#pragma unroll
                    for (int bj = 0; bj < 2; ++bj) *(u32x4*)(rowp + bj * HALF) = pack8(acc[ai][bj][m][0], acc[ai][bj][m][1]); }
        } else if (pn < 20) {
            bf16_t* VT = (bf16_t*)(mix + (pn < 16 ? MX_NSA_VST : MX_NSA_VWT)); const int col0 = (pn & 1) * BM + wc * 32 + 8 * fq;
#pragma unroll
            for (int ai = 0; ai < 2; ++ai)
#pragma unroll
                for (int m = 0; m < 4; ++m) { const int row = row0 + ai * HALF + m * 16, b = row >> 11, t = row & 2047;
                    bf16_t* p = VT + ((size_t)b * 512 + col0) * 2048 + t;
#pragma unroll
                    for (int bj = 0; bj < 2; ++bj)
#pragma unroll
                        for (int n = 0; n < 2; ++n)
#pragma unroll
                            for (int e = 0; e < 4; ++e) p[(size_t)(bj * HALF + 4 * n + e) * 2048] = bf16_1(acc[ai][bj][m][n][e]); }
        } else {
            const int c0 = 32 * wc + 8 * fq;
            if (c0 < 48) {
                const f32x4 g0 = *(const f32x4*)(gate_b + c0), g1 = *(const f32x4*)(gate_b + c0 + 4);
#pragma unroll
                for (int ai = 0; ai < 2; ++ai)
#pragma unroll
                    for (int m = 0; m < 4; ++m) { float* rowp = (float*)(mix + MX_NSA_GT) + (size_t)(row0 + ai * HALF + m * 16) * 48 + c0; f32x4 o0, o1;
#pragma unroll
                        for (int e = 0; e < 4; ++e) { o0[e] = sigmoid_f(acc[ai][0][m][0][e] + g0[e]); o1[e] = sigmoid_f(acc[ai][0][m][1][e] + g1[e]); }
                        *(f32x4*)rowp = o0; *(f32x4*)(rowp + 4) = o1; }
            }
        }
    }
};
template <class Epi, class Sched, bool ALIGN_EPI = false, bool SP2 = false, bool F16 = false>
__device__ __forceinline__ void gemm_phase(PG8_LAS unsigned char* lds, const Gemm g, const Sched& S, const Epi& E) {
    int tid_o = tidx(lds); asm volatile("" : "+v"(tid_o)); const int tid = tid_o, wid = __builtin_amdgcn_readfirstlane(tid >> 6), lane = tid & 63, wr = wid >> 2, wc = wid & 3, fr = lane & 15, fq = lane >> 4;
    const int K = g.K, nt = K / BK;
    unsigned voffA, voffB;
    { int R, C; stage_rc(tid * 16, R, C); const int Rb = Epi::PERM ? ((R & ~31) + perm32(R & 31)) : R; voffA = (unsigned)(R * K + C) * 2u; voffB = (unsigned)(Rb * K + C) * 2u; }
    const size_t qstep = (size_t)64 * K * 2;
    const size_t kstep = (size_t)(BK * 2);
    const size_t hstep = (size_t)HALF * K * 2;
    const size_t tstep = 2 * hstep;
    const unsigned ldsw = (unsigned)wid * 1024u;
    const int aoff = lds_byte(wr * 64 + fr, fq * 8), boff = lds_byte(wc * 32 + fr, fq * 8);
#define PG8_SA(b, h) (((b) * 2 + (h)) * HTB)
#define PG8_SB(b, h) ((4 + (b) * 2 + (h)) * HTB)
#define PG8_STAGE(bufoff, gbase, voff) do { _Pragma("unroll") for (int _i = 0; _i < 2; ++_i) \
        __builtin_amdgcn_global_load_lds((const unsigned*)((const char*)(gbase) + _i * qstep + (voff)), (PG8_LAS unsigned*)(lds + (bufoff) + ldsw + _i * 8192), 16, 0, 0); } while (0)
#define PG8_LDA(dst, b, h) do { _Pragma("unroll") for (int m = 0; m < 4; ++m) _Pragma("unroll") for (int k = 0; k < 2; ++k) dst[m][k] = *(const PG8_LAS bf16x8*)(lds + PG8_SA(b, h) + aoff + m * 2048 + k * 1024); } while (0)
#define PG8_LDB(dst, b, h) do { _Pragma("unroll") for (int n = 0; n < 2; ++n) _Pragma("unroll") for (int k = 0; k < 2; ++k) dst[n][k] = *(const PG8_LAS bf16x8*)(lds + PG8_SB(b, h) + boff + n * 2048 + k * 1024); } while (0)
#define PG8_MMA(ai, bj, At, Bt) do { __builtin_amdgcn_s_setprio(1); _Pragma("unroll") for (int m = 0; m < 4; ++m) _Pragma("unroll") for (int n = 0; n < 2; ++n) _Pragma("unroll") for (int k = 0; k < 2; ++k) \
        acc[ai][bj][m][n] = mma_sel<F16>(Bt[n][k], At[m][k], acc[ai][bj][m][n]); __builtin_amdgcn_s_setprio(0); } while (0)
#define PG8_WAIT_V(n) asm volatile("s_waitcnt vmcnt(" #n ")" ::: "memory")
#define PG8_WAIT_L(n) asm volatile("s_waitcnt lgkmcnt(" #n ")" ::: "memory")
#define PG8_BAR __builtin_amdgcn_s_barrier()
#define PG8_SCHED __builtin_amdgcn_sched_barrier(0)
    Unit cur, nxt; int ui = 0;
    if (!S.next(0, cur)) return;
    f32x4 acc[2][2][4][2];
#pragma unroll
    for (int a = 0; a < 2; ++a)
#pragma unroll
        for (int b = 0; b < 2; ++b)
#pragma unroll
            for (int m = 0; m < 4; ++m)
#pragma unroll
                for (int n = 0; n < 2; ++n) acc[a][b][m][n] = (f32x4){0.f, 0.f, 0.f, 0.f};
    bf16x8 At[4][2], B0[2][2], B1[2][2];
    const char* cA = (const char*)g.A + (size_t)cur.pm * tstep; const char* cB = (const char*)g.Bt + (size_t)cur.pn * tstep;
    S.a_ready(cur);
    if constexpr (SP2) {
        PG8_STAGE(PG8_SB(0, 0), cB, voffB); PG8_STAGE(PG8_SB(0, 1), cB + hstep, voffB); PG8_STAGE(PG8_SA(0, 0), cA, voffA); PG8_STAGE(PG8_SA(0, 1), cA + hstep, voffA);
        if (wr == 1) PG8_BAR;
        PG8_WAIT_V(2); PG8_BAR;
        PG8_STAGE(PG8_SB(1, 0), cB + kstep, voffB); PG8_STAGE(PG8_SA(1, 0), cA + kstep, voffA); PG8_STAGE(PG8_SB(1, 1), cB + hstep + kstep, voffB);
        PG8_WAIT_V(6); PG8_BAR;
    } else {
        PG8_STAGE(PG8_SB(0, 0), cB, voffB); PG8_STAGE(PG8_SA(0, 0), cA, voffA); PG8_STAGE(PG8_SB(0, 1), cB + hstep, voffB); PG8_STAGE(PG8_SA(0, 1), cA + hstep, voffA);
        if (wr == 1) PG8_BAR;
        PG8_WAIT_V(4); PG8_BAR;
        PG8_STAGE(PG8_SB(1, 0), cB + kstep, voffB); PG8_STAGE(PG8_SA(1, 0), cA + kstep, voffA); PG8_STAGE(PG8_SB(1, 1), cB + hstep + kstep, voffB);
        PG8_WAIT_V(6); PG8_BAR;
    }
    for (;;) {
        const bool has_next = S.next(ui + 1, nxt);
        const char* nA = has_next ? (const char*)g.A + (size_t)nxt.pm * tstep : cA; const char* nB = has_next ? (const char*)g.Bt + (size_t)nxt.pn * tstep : cB;
        for (int t = 0; t < nt; t += 2) {
            const bool last = (t == nt - 2);
            const char* a1 = cA + (size_t)(t + 1) * kstep;
            const char* a2 = last ? nA : cA + (size_t)(t + 2) * kstep; const char* b2 = last ? nB : cB + (size_t)(t + 2) * kstep;
            const char* a3 = a2 + kstep; const char* b3 = b2 + kstep;
            if (last && has_next) S.a_ready(nxt);
            if (t == nt - 4) { if constexpr (F16) stage_lnfix(E.fix, cur, tid, wid); else stage_lnfix(LnFix{E.g, E.b, E.rs, E.aux}, cur, tid, wid); }
            if constexpr (SP2) {
            PG8_LDB(B0, 0, 0); PG8_LDB(B1, 0, 1); PG8_SCHED; PG8_LDA(At, 0, 0); PG8_STAGE(PG8_SA(1, 1), a1 + hstep, voffA);
            PG8_WAIT_V(8); PG8_WAIT_L(0); PG8_BAR; PG8_MMA(0, 0, At, B0); PG8_MMA(0, 1, At, B1); PG8_BAR; PG8_SCHED;
            PG8_LDA(At, 0, 1); PG8_STAGE(PG8_SB(0, 0), b2, voffB); PG8_STAGE(PG8_SB(0, 1), b2 + hstep, voffB); PG8_STAGE(PG8_SA(0, 0), a2, voffA);
            PG8_WAIT_V(8); PG8_WAIT_L(0); PG8_BAR; PG8_MMA(1, 0, At, B0); PG8_MMA(1, 1, At, B1); PG8_BAR; PG8_SCHED;
            PG8_LDB(B0, 1, 0); PG8_LDB(B1, 1, 1); PG8_SCHED; PG8_LDA(At, 1, 0); PG8_STAGE(PG8_SA(0, 1), a2 + hstep, voffA);
            PG8_WAIT_V(8); PG8_WAIT_L(0); PG8_BAR; PG8_MMA(0, 0, At, B0); PG8_MMA(0, 1, At, B1); PG8_BAR; PG8_SCHED;
            PG8_LDA(At, 1, 1); PG8_STAGE(PG8_SB(1, 0), b3, voffB); PG8_STAGE(PG8_SB(1, 1), b3 + hstep, voffB); PG8_STAGE(PG8_SA(1, 0), a3, voffA);
            PG8_WAIT_V(8); PG8_WAIT_L(0); PG8_BAR; PG8_MMA(1, 0, At, B0); PG8_MMA(1, 1, At, B1); PG8_BAR; PG8_SCHED;
            } else {
            PG8_LDB(B0, 0, 0); PG8_SCHED; PG8_LDA(At, 0, 0); PG8_STAGE(PG8_SA(1, 1), a1 + hstep, voffA);
            PG8_WAIT_L(8); PG8_BAR; PG8_WAIT_L(0); PG8_MMA(0, 0, At, B0); PG8_BAR; PG8_SCHED;
            PG8_LDB(B1, 0, 1); PG8_STAGE(PG8_SB(0, 0), b2, voffB);
            PG8_BAR; PG8_WAIT_L(0); PG8_MMA(0, 1, At, B1); PG8_BAR;
            PG8_LDA(At, 0, 1); PG8_STAGE(PG8_SA(0, 0), a2, voffA);
            PG8_BAR; PG8_WAIT_L(0); PG8_MMA(1, 0, At, B0); PG8_BAR; PG8_SCHED;
            PG8_STAGE(PG8_SB(0, 1), b2 + hstep, voffB);
            PG8_WAIT_V(6); PG8_BAR; PG8_MMA(1, 1, At, B1); PG8_BAR;
            PG8_LDB(B0, 1, 0); PG8_SCHED; PG8_LDA(At, 1, 0); PG8_STAGE(PG8_SA(0, 1), a2 + hstep, voffA);
            PG8_WAIT_L(8); PG8_BAR; PG8_WAIT_L(0); PG8_MMA(0, 0, At, B0); PG8_BAR; PG8_SCHED;
            PG8_LDB(B1, 1, 1); PG8_STAGE(PG8_SB(1, 0), b3, voffB);
            PG8_BAR; PG8_WAIT_L(0); PG8_MMA(0, 1, At, B1); PG8_BAR;
            PG8_LDA(At, 1, 1); PG8_STAGE(PG8_SA(1, 0), a3, voffA);
            PG8_BAR; PG8_WAIT_L(0); PG8_MMA(1, 0, At, B0); PG8_BAR; PG8_SCHED;
            PG8_STAGE(PG8_SB(1, 1), b3 + hstep, voffB);
            PG8_WAIT_V(6); PG8_BAR; PG8_MMA(1, 1, At, B1); PG8_BAR;
            }
        }
        if constexpr (ALIGN_EPI) { if (wr == 0) PG8_BAR; }
        if constexpr (!Epi::AFTER_DRAIN) { E(acc, cur, wr, wc, fr, fq); S.done(cur); }
        if (!has_next) break;
#pragma unroll
        for (int a = 0; a < 2; ++a)
#pragma unroll
            for (int b = 0; b < 2; ++b)
#pragma unroll
                for (int m = 0; m < 4; ++m)
#pragma unroll
                    for (int n = 0; n < 2; ++n) acc[a][b][m][n] = (f32x4){0.f, 0.f, 0.f, 0.f};
        cur = nxt; cA = nA; cB = nB; ++ui;
        if constexpr (ALIGN_EPI) { if (wr == 1) PG8_BAR; }
    }
    PG8_WAIT_V(0);
    if constexpr (!ALIGN_EPI) { if (wr == 0) PG8_BAR; }
    PG8_BAR;
    if constexpr (Epi::AFTER_DRAIN) { E.fused(acc, cur, wr, wc, fr, fq, lds, wid, lane); S.done(cur); }
#undef PG8_SA
#undef PG8_SB
#undef PG8_STAGE
#undef PG8_LDA
#undef PG8_LDB
#undef PG8_MMA
#undef PG8_WAIT_V
#undef PG8_WAIT_L
#undef PG8_BAR
#undef PG8_SCHED
}
}
#ifndef PG8_SP2
#define PG8_SP2 true
#endif
#ifndef PG8_ALIGN
#define PG8_ALIGN true
#endif
constexpr int NB = 16, T = 2048, D = 2048, M = NB * T, DFF = 5632, DEPTH = 4, NWAVES = 8;
constexpr float LN_EPS = 1e-5f, ALPHA = 1.6817928305074292f;
constexpr int NSA_NPAD = 5376, NSA_NSRC = 5168, CONV_N = 6144, GLA_NPAD = 6400, GLA_NSRC = 6160;
enum { I_X = 0, I_POS, I_LNG, I_LNB, I_FFN_WIN, I_FFN_WOUT, I_NSA_WIN, I_NSA_GB, I_NSA_CPOS, I_NSA_CW1, I_NSA_CW2, I_NSA_WOUT,
       I_CONV_WIN, I_CONV_W, I_CONV_WOUT, I_GLA_WIN, I_GLA_WA2, I_GLA_BA, I_GLA_NG, I_GLA_WOUT, N_IN };
constexpr size_t WS_CTL = 0, CTL_ZERO_BYTES = 1 * MiB;
constexpr size_t WS_COS = 1 * MiB, WS_SIN = 9 * MiB;
constexpr size_t WS_MISC = 17 * MiB;
constexpr size_t WS_RS = WS_MISC + 256 * 1024;
constexpr size_t SZ_FFN_WIN = (size_t)2 * DFF * D * 2, SZ_FFN_WOUT = (size_t)D * DFF * 2;
constexpr size_t WS_FFN_WIN = 18 * MiB, WS_FFN_WOUT = WS_FFN_WIN + 8 * SZ_FFN_WIN;
constexpr size_t SZ_NSA_WIN = (size_t)NSA_NPAD * D * 2, SZ_DD = (size_t)D * D * 2;
constexpr size_t WS_NSA_WIN = WS_FFN_WOUT + 8 * SZ_FFN_WOUT, WS_NSA_WOUT = WS_NSA_WIN + 2 * SZ_NSA_WIN;
constexpr size_t WS_CONV_WIN = WS_NSA_WOUT + 2 * SZ_DD, WS_CONV_WOUT = WS_CONV_WIN + (size_t)CONV_N * D * 2;
constexpr size_t WS_GLA_WIN = WS_CONV_WOUT + SZ_DD, WS_GLA_WOUT = WS_GLA_WIN + (size_t)GLA_NPAD * D * 2;
constexpr size_t WS_CMP_W1T = WS_GLA_WOUT + SZ_DD, WS_CMP_W2T = WS_CMP_W1T + 4 * (size_t)128 * 4096 * 2;
constexpr size_t WS_XB = WS_CMP_W2T + 1 * MiB;
constexpr size_t WS_MIX = WS_XB + (size_t)M * D * 2;
constexpr size_t WS_A2 = WS_MIX + 640 * MiB;
constexpr size_t WS_PS = WS_A2 + (size_t)M * D * 2;
constexpr size_t WS_PART = WS_PS + 16 * MiB;
constexpr size_t WS_CSBV = WS_PART + 12 * 4 * MiB;
constexpr size_t WS_ZDUMMY = WS_CSBV + 2 * MiB;
constexpr size_t WS_END = WS_ZDUMMY + (size_t)M * D * 2;
static_assert(WS_FFN_WIN % 256 == 0 && WS_NSA_WIN % 256 == 0 && WS_XB % 256 == 0 && WS_MIX % 256 == 0, "ws alignment");
static_assert((size_t)M * DFF * 2 <= 640 * MiB, "H fits the mixer region");
constexpr int CW_BAR = 4096;
constexpr int RING_OFF = 0, RING_BYTES = 131072;
constexpr int LDSCTL_OFF = 144896, MISC_OFF = LDSCTL_OFF + 320;
constexpr int LDS_BYTES = 147456;
static_assert(MISC_OFF + 128 <= LDS_BYTES, "LDS map");
static_assert(pg8::WIDTAB_BYTE == LDSCTL_OFF + 1024 && pg8::WIDTAB_BYTE + 256 <= LDS_BYTES && RING_OFF == 0, "wave-index table");

#define GAS __attribute__((address_space(1)))
#define LAS __attribute__((address_space(3)))
typedef unsigned short bf16;
typedef unsigned v4u __attribute__((ext_vector_type(4)));
typedef unsigned v2u __attribute__((ext_vector_type(2)));
typedef float f32x4 __attribute__((ext_vector_type(4)));
typedef short bf16x8 __attribute__((ext_vector_type(8)));
#define LDS_WAIT() asm volatile("s_waitcnt lgkmcnt(0)" ::: "memory")
#define VM_WAIT() asm volatile("s_waitcnt vmcnt(0)" ::: "memory")
__device__ __forceinline__ unsigned pk2(float lo, float hi) { return pg8::cvt_pk_bf16(lo, hi); }
__device__ __forceinline__ float bf_lo(unsigned w) { return __builtin_bit_cast(float, w << 16); }
__device__ __forceinline__ float bf_hi(unsigned w) { return __builtin_bit_cast(float, w & 0xffff0000u); }
#define XB_TMO      128
#define XB_XCNT(j)  (256  + 64 * (j))
#define XB_XSUB(j)  (1280 + 64 * (j))
#define XB_XGEN(j)  (2304 + 64 * (j))
#define XB_TOP      3328
#define XB_TOPGEN   3392
#define XCD_BAR_WORDS 3456
#define XB_SPIN_CAP (1u << 18)

__device__ __forceinline__ unsigned xb_ld(unsigned* p)              { return __hip_atomic_load(p, __ATOMIC_RELAXED, __HIP_MEMORY_SCOPE_AGENT); }
__device__ __forceinline__ unsigned xb_add(unsigned* p, unsigned v) { return __hip_atomic_fetch_add(p, v, __ATOMIC_RELAXED, __HIP_MEMORY_SCOPE_AGENT); }
__device__ __forceinline__ unsigned xb_xcc_id() { return (unsigned)__builtin_amdgcn_s_getreg((3 << 11) | 20) & 0xFu; }
#define XB_SPIN(cond, bar) do { unsigned _sp = 0; while (cond) { __builtin_amdgcn_s_sleep(1); \
    if ((++_sp & 255u) == 0u) { if (xb_ld(&(bar)[XB_TMO])) break; if (_sp > XB_SPIN_CAP) { atomicAdd(&(bar)[XB_TMO], 1u); break; } } } } while (0)

struct XcdBarrier {
    unsigned* bar; unsigned x;
    volatile LAS unsigned* st;
};

__device__ __forceinline__ XcdBarrier xcd_barrier_post(unsigned* bar, volatile LAS unsigned* st) {
    XcdBarrier b; b.bar = bar; b.x = xb_xcc_id(); b.st = st;
    if (pg8::tidx((const LAS unsigned char*)st - (MISC_OFF + 32)) == 0) (void)xb_add(&bar[XB_XCNT(b.x)], 1u);
    return b;
}
__device__ __forceinline__ void xcd_barrier_complete(unsigned* bar, unsigned x, unsigned& nloc, unsigned& nx) {
    const unsigned G = gridDim.x * gridDim.y * gridDim.z;
    unsigned sum, cnt, mine, sp = 0u;
    for (;;) {
        sum = 0u; cnt = 0u; mine = 0u;
#pragma unroll
        for (unsigned j = 0; j < 16; ++j) { const unsigned c = xb_ld(&bar[XB_XCNT(j)]); sum += c; cnt += (c > 0u) ? 1u : 0u; mine = (j == x) ? c : mine; }
        if (sum == G) break;
        __builtin_amdgcn_s_sleep(1);
        if ((++sp & 255u) == 0u) { if (xb_ld(&bar[XB_TMO])) break; if (sp > XB_SPIN_CAP) { atomicAdd(&bar[XB_TMO], 1u); break; } }
    }
    nloc = mine > 0u ? mine : 1u; nx = cnt > 0u ? cnt : 1u;
}

__device__ __forceinline__ void xcd_barrier(const XcdBarrier& b) {
    asm volatile("s_waitcnt vmcnt(0)" ::: "memory");
    __syncthreads();
    if (pg8::tidx((const LAS unsigned char*)b.st - (MISC_OFF + 32)) == 0) {
        unsigned* bar = b.bar; asm volatile("" : "+s"(bar));
        __builtin_amdgcn_s_waitcnt(0);
        unsigned nloc = b.st[0], nx = b.st[1];
        if (nloc == 0u) { xcd_barrier_complete(bar, b.x, nloc, nx); b.st[0] = nloc; b.st[1] = nx; }
        unsigned bx_ = b.x; asm volatile("" : "+s"(bx_));
        const unsigned old = xb_add(&bar[XB_XSUB(bx_)], 1u);
        const unsigned gen = old / nloc;
        if (old + 1u == (gen + 1u) * nloc) {
            __builtin_amdgcn_fence(__ATOMIC_RELEASE, "agent");
            asm volatile("s_waitcnt vmcnt(0)" ::: "memory");
            const unsigned og = xb_add(&bar[XB_TOP], 1u);
            const unsigned tg = og / nx;
            if (og + 1u == (tg + 1u) * nx) xb_add(&bar[XB_TOPGEN], 1u);
            else XB_SPIN(xb_ld(&bar[XB_TOPGEN]) == tg, bar);
            __builtin_amdgcn_fence(__ATOMIC_ACQUIRE, "agent");
            xb_add(&bar[XB_XGEN(bx_)], 1u);
            asm volatile("s_waitcnt vmcnt(0)" ::: "memory");
        } else {
            XB_SPIN(xb_ld(&bar[XB_XGEN(bx_)]) == gen, bar);
            __builtin_amdgcn_fence(__ATOMIC_ACQUIRE, "agent");
            asm volatile("s_waitcnt vmcnt(0)" ::: "memory");
        }
    }
    __syncthreads();
}
template <int KSTEPS>
__device__ __forceinline__ f32x4 mma16(f32x4 acc, const LAS unsigned char* Aimg, int strideA, int m0, const LAS unsigned char* Bimg, int strideB, int n0, int lane) {
    const LAS unsigned char* ap = Aimg + (m0 + (lane & 15)) * strideA + (lane >> 4) * 16;
    const LAS unsigned char* bp = Bimg + (n0 + (lane & 15)) * strideB + (lane >> 4) * 16;
#pragma unroll
    for (int ks = 0; ks < KSTEPS; ++ks) {
        const bf16x8 a = *(const LAS bf16x8*)(ap + ks * 64), b = *(const LAS bf16x8*)(bp + ks * 64);
        acc = __builtin_amdgcn_mfma_f32_16x16x32_bf16(a, b, acc, 0, 0, 0);
    }
    return acc;
}

__device__ __forceinline__ float logsigmoid_f(float z) { return fminf(z, 0.f) - __logf(1.f + __expf(-fabsf(z))); }
__device__ __forceinline__ void gla_prep(unsigned char* ws, const float* w_a2, const float* b_a, LAS unsigned char* lds, int vcu, int G) {
    int tid = pg8::tidx(lds); asm volatile("" : "+v"(tid));
    bf16* Q = (bf16*)(ws + WS_MIX + MX_GLA_Q); bf16* K = (bf16*)(ws + WS_MIX + MX_GLA_K);
    const float* A = (const float*)(ws + WS_MIX + MX_GLA_A); float* DEC = (float*)(ws + WS_MIX + MX_GLA_DEC);
    LAS float* la = (LAS float*)lds;
    LAS float* lt = (LAS float*)(lds + 4096);
    const int d = tid & 255, half = tid >> 8;
    for (int item = vcu; item < NB * 32 * 4; item += G) {
        const int h = item & 3, n = (item >> 2) & 31, b = item >> 7; const int col = h * 256 + d; const size_t row0 = (size_t)b * T + n * 64;
        __syncthreads();
        for (int i = tid; i < 64 * 16; i += 512) la[i] = A[row0 * 16 + i];
        float w[16];
#pragma unroll
        for (int j = 0; j < 16; ++j) w[j] = w_a2[(size_t)j * 1024 + col];
        const float ba = b_a[col];
        __syncthreads();
        float bc[32]; float run = 0.f;
#pragma unroll
        for (int r = 0; r < 32; ++r) { const LAS f32x4* ar = (const LAS f32x4*)(la + (half * 32 + r) * 16); float z = ba;
#pragma unroll
            for (int j4 = 0; j4 < 4; ++j4) { const f32x4 av = ar[j4]; z += (av[0] * w[4 * j4] + av[1] * w[4 * j4 + 1]) + (av[2] * w[4 * j4 + 2] + av[3] * w[4 * j4 + 3]); }
            run += logsigmoid_f(z) * (1.f / 16.f); bc[r] = run; }
        if (half == 0) lt[d] = run;
        __syncthreads();
        const float tot0 = lt[d]; const float off = half ? tot0 : 0.f; const float blast = half ? (tot0 + run) : 0.f;
        if (half == 1) lt[d] = blast;
        __syncthreads();
        const float bl = lt[d];
        if (half == 1) DEC[((size_t)b * 32 + n) * 1024 + col] = __expf(bl);
#pragma unroll
        for (int r = 0; r < 32; ++r) { const size_t gi = (row0 + half * 32 + r) * 1024 + col; const float bb = bc[r] + off;
            const float qv = bf_lo((unsigned)Q[gi]), kv = bf_lo((unsigned)K[gi]);
            const float eb = __expf(bb); Q[gi] = pg8::bf16_1(qv * eb); K[gi] = pg8::bf16_1(kv * __builtin_amdgcn_rcpf(eb)); }
    }
}
constexpr int GL_SQ = 544, GL_S64 = 160;
constexpr int GL_QD = 0, GL_KD = GL_QD + 64 * GL_SQ, GL_VT = GL_KD + 64 * GL_SQ, GL_ST = GL_VT + 64 * GL_S64, GL_AI = GL_ST + 64 * GL_SQ, GL_SS = GL_AI + 64 * GL_S64, GL_END = GL_SS + 64 * 4 * 4;
static_assert(GL_END <= LDSCTL_OFF, "GLA LDS map");
typedef short v4i16_t __attribute__((ext_vector_type(4)));
__device__ __forceinline__ void gla_scan(unsigned char* ws, LAS unsigned char* lds, int vcu, int G) {
    int tid = pg8::tidx(lds); asm volatile("" : "+v"(tid));
    const int lane = tid & 63, w = __builtin_amdgcn_readfirstlane(tid >> 6);
    const bf16* QD = (const bf16*)(ws + WS_MIX + MX_GLA_Q); const bf16* KD = (const bf16*)(ws + WS_MIX + MX_GLA_K); const bf16* VTg = (const bf16*)(ws + WS_MIX + MX_GLA_VT);
    const float* DEC = (const float*)(ws + WS_MIX + MX_GLA_DEC);
    bf16* O = (bf16*)(ws + WS_MIX + MX_GLA_O); float* SSQ = (float*)(ws + WS_MIX + MX_GLA_SSQ);
    for (int unit = vcu; unit < NB * 4 * 8; unit += G) {
        const int vs = unit & 7, h = (unit >> 3) & 3, b = unit >> 5;
        f32x4 st[8];
#pragma unroll
        for (int i = 0; i < 8; ++i) st[i] = (f32x4){0.f, 0.f, 0.f, 0.f};
        v4u q4[4], k4[4], v1;
#define GLA_LOAD_TILES(nn) do { const size_t r0_ = (size_t)b * T + (nn) * 64; _Pragma("unroll") for (int i = 0; i < 4; ++i) { const int c = tid + 512 * i, r = c >> 5, cc = c & 31; \
            q4[i] = *(const v4u*)(QD + (r0_ + r) * 1024 + h * 256 + cc * 8); k4[i] = *(const v4u*)(KD + (r0_ + r) * 1024 + h * 256 + cc * 8); } \
            { const int r = tid >> 3, cc = tid & 7; v1 = *(const v4u*)(VTg + ((size_t)b * 2048 + h * 512 + vs * 64 + r) * 2048 + (nn) * 64 + cc * 8); } } while (0)
#define GLA_STORE_TILES() do { _Pragma("unroll") for (int i = 0; i < 4; ++i) { const int c = tid + 512 * i, r = c >> 5, cc = c & 31; *(LAS v4u*)(lds + GL_QD + r * GL_SQ + cc * 16) = q4[i]; *(LAS v4u*)(lds + GL_KD + r * GL_SQ + cc * 16) = k4[i]; } \
            { const int r = tid >> 3, cc = tid & 7; *(LAS v4u*)(lds + GL_VT + r * GL_S64 + cc * 16) = v1; } } while (0)
        GLA_LOAD_TILES(0);
        __syncthreads();
        { unsigned z = 0u; asm volatile("" : "+v"(z)); for (int i = tid; i < 64 * GL_SQ / 16; i += 512) *(LAS v4u*)(lds + GL_ST + i * 16) = (v4u){z, z, z, z}; }
        GLA_STORE_TILES();
        for (int n = 0; n < 32; ++n) {
            const size_t row0 = (size_t)b * T + n * 64;
            __syncthreads();
            if (n < 31) GLA_LOAD_TILES(n + 1);
            {
                const int tm = w >> 1;
#pragma unroll
                for (int j = 0; j < 2; ++j) { const int tn = 2 * (w & 1) + j; f32x4 a = (f32x4){0.f, 0.f, 0.f, 0.f};
                    if (tn <= tm) a = mma16<8>(a, lds + GL_QD, GL_SQ, tm * 16, lds + GL_KD, GL_SQ, tn * 16, lane);
                    const int sx = tn * 16 + (lane & 15);
#pragma unroll
                    for (int r = 0; r < 4; ++r) { const int c = tm * 16 + 4 * (lane >> 4) + r; const float v = (sx <= c) ? a[r] : 0.f;
                        *(LAS unsigned short*)(lds + GL_AI + c * GL_S64 + sx * 2) = pg8::bf16_1(v); } }
            }
            {
                const int g4 = lane >> 4, q = (lane & 15) >> 2, p = lane & 3;
#pragma unroll
                for (int dt = 0; dt < 2; ++dt) { const int dtile = 2 * w + dt; const float dec = DEC[((size_t)b * 32 + n) * 1024 + h * 256 + dtile * 16 + (lane & 15)];
                    bf16x8 bfr[2];
#pragma unroll
                    for (int ks = 0; ks < 2; ++ks) { const LAS unsigned char* kp = lds + GL_KD + (32 * ks + 8 * g4 + q) * GL_SQ + (16 * dtile + 4 * p) * 2;
                        const v4i16_t lo = __builtin_amdgcn_ds_read_tr16_b64_v4i16((LAS v4i16_t*)kp), hi = __builtin_amdgcn_ds_read_tr16_b64_v4i16((LAS v4i16_t*)(kp + 4 * GL_SQ));
                        bfr[ks] = (bf16x8){lo[0], lo[1], lo[2], lo[3], hi[0], hi[1], hi[2], hi[3]}; }
#pragma unroll
                    for (int vt = 0; vt < 4; ++vt) { f32x4 a = st[dt * 4 + vt];
                        const LAS unsigned char* ap = lds + GL_VT + (vt * 16 + (lane & 15)) * GL_S64 + (lane >> 4) * 16;
#pragma unroll
                        for (int ks = 0; ks < 2; ++ks) a = __builtin_amdgcn_mfma_f32_16x16x32_bf16(*(const LAS bf16x8*)(ap + ks * 64), bfr[ks], a, 0, 0, 0);
                        st[dt * 4 + vt] = a * dec; } }
            }
            __syncthreads();
            {
                const int tm = w >> 1;
#pragma unroll
                for (int j = 0; j < 2; ++j) { const int tn = 2 * (w & 1) + j; f32x4 o = (f32x4){0.f, 0.f, 0.f, 0.f};
                    o = mma16<2>(o, lds + GL_AI, GL_S64, tm * 16, lds + GL_VT, GL_S64, tn * 16, lane);
                    o = mma16<8>(o, lds + GL_QD, GL_SQ, tm * 16, lds + GL_ST, GL_SQ, tn * 16, lane);
                    const int v = tn * 16 + (lane & 15);
#pragma unroll
                    for (int r = 0; r < 4; ++r) { const int c = tm * 16 + 4 * (lane >> 4) + r;
                        O[(row0 + c) * 2048 + h * 512 + vs * 64 + v] = pg8::bf16_1(o[r]);
                        float qq = o[r] * o[r]; qq += __shfl_xor(qq, 1); qq += __shfl_xor(qq, 2); qq += __shfl_xor(qq, 4); qq += __shfl_xor(qq, 8);
                        if ((lane & 15) == 0) *(LAS float*)(lds + GL_SS + (c * 4 + tn) * 4) = qq; } }
            }
            __syncthreads();
            if (tid < 64) { const LAS float* pp = (const LAS float*)(lds + GL_SS + tid * 16); SSQ[(row0 + tid) * 32 + h * 8 + vs] = (pp[0] + pp[1]) + (pp[2] + pp[3]); }
#pragma unroll
            for (int dt = 0; dt < 2; ++dt) { const int dcol = (2 * w + dt) * 16 + (lane & 15);
#pragma unroll
                for (int vt = 0; vt < 4; ++vt)
#pragma unroll
                    for (int r = 0; r < 4; ++r) { const int v = vt * 16 + 4 * (lane >> 4) + r; *(LAS unsigned short*)(lds + GL_ST + v * GL_SQ + dcol * 2) = pg8::bf16_1(st[dt * 4 + vt][r]); } }
            if (n < 31) GLA_STORE_TILES();
        }
    }
}
__device__ __forceinline__ void gla_out(unsigned char* ws, const float* norm_g, bf16* XB, int vcu, int NT, const LAS unsigned char* lds) {
    int gtid = pg8::tidx(lds); asm volatile("" : "+v"(gtid)); gtid += vcu * (NWAVES * 64);
    const bf16* O = (const bf16*)(ws + WS_MIX + MX_GLA_O); const bf16* R = (const bf16*)(ws + WS_MIX + MX_GLA_R); const float* SSQ = (const float*)(ws + WS_MIX + MX_GLA_SSQ);
    for (int idx = gtid; idx < M * 256; idx += NT) {
        const int m = idx >> 8, col = (idx & 255) * 8, h = col >> 9, v = col & 511;
        const f32x4 s0 = *(const f32x4*)(SSQ + (size_t)m * 32 + h * 8), s1 = *(const f32x4*)(SSQ + (size_t)m * 32 + h * 8 + 4);
        const float ss = ((s0.x + s0.y) + (s0.z + s0.w)) + ((s1.x + s1.y) + (s1.z + s1.w));
        const float rs = 1.f / sqrtf(ss * (1.f / 512.f) + LN_EPS);
        const v4u o = *(const v4u*)(O + (size_t)m * D + col), r = *(const v4u*)(R + (size_t)m * D + col);
        const f32x4 g0 = *(const f32x4*)(norm_g + v), g1 = *(const f32x4*)(norm_g + v + 4);
        float y[8];
#pragma unroll
        for (int p = 0; p < 4; ++p) { const float gl = p < 2 ? g0[2 * p] : g1[2 * p - 4], gh = p < 2 ? g0[2 * p + 1] : g1[2 * p - 3];
            y[2 * p] = bf_lo(o[p]) * rs * gl * bf_lo(r[p]); y[2 * p + 1] = bf_hi(o[p]) * rs * gh * bf_hi(r[p]); }
        v4u w; w.x = pk2(y[0], y[1]); w.y = pk2(y[2], y[3]); w.z = pk2(y[4], y[5]); w.w = pk2(y[6], y[7]);
        *(v4u*)(XB + (size_t)m * D + col) = w;
    }
}
constexpr float NSA_QSCALE = 0.08838834764831845f * 1.4426950408889634f;
typedef float f32x16 __attribute__((ext_vector_type(16)));
typedef short s16x4 __attribute__((ext_vector_type(4)));

__device__ __forceinline__ float gelu_tanh_f(float x) { const float u = 0.7978845608028654f * (x + 0.044715f * x * x * x); const float e = __expf(2.f * u); const float th = 1.f - 2.f * __builtin_amdgcn_rcpf(e + 1.f); return 0.5f * x * (1.f + th); }

constexpr int CP_HID = 0, CP_HS = 288, CP_A0 = 32768;
__device__ __forceinline__ void nsa_compress(unsigned char* ws, int mj, LAS unsigned char* lds, int vcu, int G) {
    for (int unit = vcu; unit < NB * 4 * 2 * 2; unit += G) {
        int tid = pg8::tidx(lds); asm volatile("" : "+v"(tid));
        const int lane = tid & 63, w = __builtin_amdgcn_readfirstlane(tid >> 6);
        const int nh = unit & 1, kv = (unit >> 1) & 1, g = (unit >> 2) & 3, b = unit >> 4, f = mj * 2 + kv;
        const bf16* src = (const bf16*)(ws + WS_MIX + (kv ? MX_NSA_VC : MX_NSA_KC)) + (size_t)b * T * 512 + g * 128;
        const bf16* w1t = (const bf16*)(ws + WS_CMP_W1T) + (size_t)f * 128 * 4096;
        const bf16* w2t = (const bf16*)(ws + WS_CMP_W2T) + (size_t)f * 128 * 128;
        const float* bias1 = (const float*)(ws + WS_MISC) + f * 128;
        f32x4 acc[4];
#pragma unroll
        for (int i = 0; i < 4; ++i) acc[i] = (f32x4){0.f, 0.f, 0.f, 0.f};
        const bf16* bp = w1t + (size_t)(16 * w + (lane & 15)) * 4096 + (lane >> 4) * 8;
        v4u ar0[2], ar1[2]; bf16x8 bfa[4], bfb[4];
#define CP_ALOAD(AR, L) do { _Pragma("unroll") for (int i = 0; i < 2; ++i) { const int c = tid + 512 * i; int t = 16 * (nh * 64 + (c >> 4)) + (L); t = t > T - 1 ? T - 1 : t; \
            AR[i] = *(const v4u*)(src + (size_t)t * 512 + (c & 15) * 8); } } while (0)
#define CP_ASTORE(AR, BUF) do { _Pragma("unroll") for (int i = 0; i < 2; ++i) { const int c = tid + 512 * i, row = c >> 4; \
            *(LAS v4u*)(lds + CP_A0 + (BUF) * 16384 + row * 256 + (((c & 15) ^ (row & 15)) << 4)) = AR[i]; } } while (0)
#define CP_BLOAD(BFR, L) do { _Pragma("unroll") for (int q4 = 0; q4 < 4; ++q4) BFR[q4] = *(const bf16x8*)(bp + ((L) * 4 + q4) * 32); } while (0)
#define CP_MMA(BFR, BUF) do { _Pragma("unroll") for (int mt = 0; mt < 4; ++mt) { const int row = mt * 16 + (lane & 15); const LAS unsigned char* rp = lds + CP_A0 + (BUF) * 16384 + row * 256; \
            _Pragma("unroll") for (int q4 = 0; q4 < 4; ++q4) acc[mt] = __builtin_amdgcn_mfma_f32_16x16x32_bf16(*(const LAS bf16x8*)(rp + (((q4 * 4 + (lane >> 4)) ^ (row & 15)) << 4)), BFR[q4], acc[mt], 0, 0, 0); } } while (0)
        CP_ALOAD(ar0, 0); CP_ALOAD(ar1, 1); CP_BLOAD(bfa, 0);
        __syncthreads();
        CP_ASTORE(ar0, 0);
#pragma unroll 1
        for (int l = 0; l < 32; l += 2) {
            __syncthreads();
            if (l + 2 < 32) CP_ALOAD(ar0, l + 2);
            CP_BLOAD(bfb, l + 1);
            CP_MMA(bfa, 0);
            CP_ASTORE(ar1, 1);
            __syncthreads();
            if (l + 2 < 32) { CP_ALOAD(ar1, l + 3); CP_BLOAD(bfa, l + 2); }
            CP_MMA(bfb, 1);
            if (l + 2 < 32) CP_ASTORE(ar0, 0);
        }
#undef CP_ALOAD
#undef CP_ASTORE
#undef CP_BLOAD
#undef CP_MMA
        const float b1 = bias1[16 * w + (lane & 15)];
        __syncthreads();
#pragma unroll
        for (int mt = 0; mt < 4; ++mt)
#pragma unroll
            for (int r = 0; r < 4; ++r) { const int n = mt * 16 + 4 * (lane >> 4) + r; *(LAS unsigned short*)(lds + CP_HID + n * CP_HS + (16 * w + (lane & 15)) * 2) = pg8::bf16_1(gelu_tanh_f(acc[mt][r] + b1)); }
        __syncthreads();
        const bf16* b2p = w2t + (size_t)(16 * w + (lane & 15)) * 128 + (lane >> 4) * 8;
        bf16x8 b2[4];
#pragma unroll
        for (int ks = 0; ks < 4; ++ks) b2[ks] = *(const bf16x8*)(b2p + ks * 32);
#pragma unroll
        for (int mt = 0; mt < 4; ++mt) { f32x4 o = (f32x4){0.f, 0.f, 0.f, 0.f};
            const LAS unsigned char* ap = lds + CP_HID + (mt * 16 + (lane & 15)) * CP_HS + (lane >> 4) * 16;
#pragma unroll
            for (int ks = 0; ks < 4; ++ks) o = __builtin_amdgcn_mfma_f32_16x16x32_bf16(*(const LAS bf16x8*)(ap + ks * 64), b2[ks], o, 0, 0, 0);
            const int d2 = 16 * w + (lane & 15);
#pragma unroll
            for (int r = 0; r < 4; ++r) { const int n = nh * 64 + mt * 16 + 4 * (lane >> 4) + r; const unsigned short v = n < 127 ? pg8::bf16_1(o[r]) : (unsigned short)0;
                if (kv == 0) ((bf16*)(ws + WS_MIX + MX_NSA_KCMP))[((size_t)(b * 4 + g) * 128 + n) * 128 + d2] = v;
                else         ((bf16*)(ws + WS_MIX + MX_NSA_VCMPT))[((size_t)(b * 4 + g) * 128 + d2) * 128 + n] = v; } }
    }
}

constexpr int AT_K0 = 0, AT_KB = 16384, AT_V0 = 32768, AT_VS = 144, AT_VB = 128 * AT_VS, AT_MASK = AT_V0 + 2 * AT_VB, AT_IMP = AT_MASK + 256, AT_OC = AT_IMP, AT_END = AT_OC + 16 * 512 * 8;
static_assert(AT_END <= LDSCTL_OFF, "attention LDS map");
enum { MODE_CMP = 0, MODE_SEL = 1, MODE_WIN = 2 };
__device__ __forceinline__ void at_load(v4u (&kr)[2], v4u (&vr)[2], const bf16* Kb, int pitchK, const bf16* Vb, int pitchV, int j, int tid) {
    const unsigned ko = (unsigned)(((tid >> 4) * pitchK + (tid & 15) * 8) * 2), vo = (unsigned)(((tid >> 3) * pitchV + (tid & 7) * 8) * 2);
    const unsigned char* kbj = (const unsigned char*)(Kb + (size_t)j * 64 * pitchK); const unsigned char* vbj = (const unsigned char*)(Vb + j * 64);
    kr[0] = *(const v4u*)(kbj + ko); kr[1] = *(const v4u*)(kbj + (size_t)64 * pitchK + ko);
    vr[0] = *(const v4u*)(vbj + vo); vr[1] = *(const v4u*)(vbj + (size_t)128 * pitchV + vo);
}
__device__ __forceinline__ void at_store(const v4u (&kr)[2], const v4u (&vr)[2], LAS unsigned char* lds, int buf, int tid) {
#pragma unroll
    for (int i = 0; i < 2; ++i) { const int c = tid + 512 * i; const int row = c >> 4, slot = c & 15;
        *(LAS v4u*)(lds + AT_K0 + buf * AT_KB + row * 256 + ((slot ^ (row & 15)) << 4)) = kr[i];
        LAS unsigned char* vp = lds + AT_V0 + buf * AT_VB + (c >> 3) * AT_VS + ((c & 7) >> 1) * 32 + (c & 1) * 8;
        *(LAS v2u*)vp = (v2u){vr[i].x, vr[i].y}; *(LAS v2u*)(vp + 16) = (v2u){vr[i].z, vr[i].w}; }
}
__device__ __forceinline__ f32x16 at_qk(const LAS unsigned char* kb, int kt, const bf16x8 (&qf)[8], int lane) {
    f32x16 s;
#pragma unroll
    for (int i = 0; i < 16; ++i) s[i] = 0.f;
    const int row = kt * 32 + (lane & 31); const LAS unsigned char* rp = kb + row * 256; const int sw = (row & 15) << 4, hb = (lane >> 5) << 4;
#pragma unroll
    for (int kk = 0; kk < 8; ++kk) { const bf16x8 a = *(const LAS bf16x8*)(rp + ((32 * kk + hb) ^ sw)); s = __builtin_amdgcn_mfma_f32_32x32x16_bf16(a, qf[kk], s, 0, 0, 0); }
    return s;
}
__device__ __forceinline__ void at_pv(f32x16 (&o)[4], const LAS unsigned char* vb, int kt, const f32x16& p, int lane) {
#pragma unroll
    for (int s2 = 0; s2 < 2; ++s2) {
        bf16x8 pf;
        { v4u t; t.x = pk2(p[8 * s2 + 0], p[8 * s2 + 1]); t.y = pk2(p[8 * s2 + 2], p[8 * s2 + 3]); t.z = pk2(p[8 * s2 + 4], p[8 * s2 + 5]); t.w = pk2(p[8 * s2 + 6], p[8 * s2 + 7]); pf = __builtin_bit_cast(bf16x8, t); }
        const int cb = 64 * kt + 32 * s2 + 16 * (lane >> 5);
#pragma unroll
        for (int dt = 0; dt < 4; ++dt) { const bf16x8 a = *(const LAS bf16x8*)(vb + (32 * dt + (lane & 31)) * AT_VS + cb);
            o[dt] = __builtin_amdgcn_mfma_f32_32x32x16_bf16(a, pf, o[dt], 0, 0, 0); }
    }
}
__device__ __forceinline__ void at_kload(bf16x8 (&ka)[16], const LAS unsigned char* kb, int lane) {
#pragma unroll
    for (int kt = 0; kt < 2; ++kt) { const int row = kt * 32 + (lane & 31); const LAS unsigned char* rp = kb + row * 256; const int sw = (row & 15) << 4, hb = (lane >> 5) << 4;
#pragma unroll
        for (int kk = 0; kk < 8; ++kk) ka[kt * 8 + kk] = *(const LAS bf16x8*)(rp + ((32 * kk + hb) ^ sw)); }
}
__device__ __forceinline__ void at_vload(bf16x8 (&va)[8], const LAS unsigned char* vb, int kt, int lane) {
    const LAS unsigned char* vp = vb + (lane & 31) * AT_VS + 16 * (lane >> 5) + 64 * kt;
#pragma unroll
    for (int s2 = 0; s2 < 2; ++s2)
#pragma unroll
        for (int dt = 0; dt < 4; ++dt) va[s2 * 4 + dt] = *(const LAS bf16x8*)(vp + 32 * dt * AT_VS + 32 * s2);
}
template <int S2>
__device__ __forceinline__ void at_pv_r(f32x16 (&o)[4], const bf16x8 (&va)[8], const f32x16& p) {
    bf16x8 pf;
    { v4u t; t.x = pk2(p[8 * S2 + 0], p[8 * S2 + 1]); t.y = pk2(p[8 * S2 + 2], p[8 * S2 + 3]); t.z = pk2(p[8 * S2 + 4], p[8 * S2 + 5]); t.w = pk2(p[8 * S2 + 6], p[8 * S2 + 7]); pf = __builtin_bit_cast(bf16x8, t); }
#pragma unroll
    for (int dt = 0; dt < 4; ++dt) o[dt] = __builtin_amdgcn_mfma_f32_32x32x16_bf16(va[S2 * 4 + dt], pf, o[dt], 0, 0, 0);
}
template <bool FIRST>
__device__ __forceinline__ void oc_add(LAS unsigned char* lds, int tid, const f32x16 (&o)[4], float f) {
#pragma unroll
    for (int dt = 0; dt < 4; ++dt)
#pragma unroll
        for (int g4 = 0; g4 < 4; ++g4) { LAS v2u* cp = (LAS v2u*)(lds + AT_OC + (dt * 4 + g4) * 4096 + tid * 8); v2u c = FIRST ? (v2u){0u, 0u} : *cp;
            c.x = pk2(bf_lo(c.x) + f * o[dt][4 * g4 + 0], bf_hi(c.x) + f * o[dt][4 * g4 + 1]);
            c.y = pk2(bf_lo(c.y) + f * o[dt][4 * g4 + 2], bf_hi(c.y) + f * o[dt][4 * g4 + 3]); *cp = c; }
}
template <int MODE>
__device__ __forceinline__ void at_step(f32x16 (&o)[4], float& m, float& l, const bf16x8 (&qf)[8], const LAS unsigned char* kb, const LAS unsigned char* vb, int j, int qb, int tq, unsigned mword, int lane) {
    f32x16 s0, s1; bf16x8 fa[8], fb[8];
#pragma unroll
    for (int i = 0; i < 16; ++i) { s0[i] = 0.f; s1[i] = 0.f; }
    {
        const int r0 = lane & 31, sw = (r0 & 15) << 4, hb = (lane >> 5) << 4; const LAS unsigned char* rp = kb + r0 * 256;
#pragma unroll
        for (int kk = 0; kk < 8; ++kk) fa[kk] = *(const LAS bf16x8*)(rp + ((32 * kk + hb) ^ sw));
#pragma unroll
        for (int kk = 0; kk < 4; ++kk) fb[kk] = *(const LAS bf16x8*)(rp + 32 * 256 + ((32 * kk + hb) ^ sw));
        __builtin_amdgcn_sched_barrier(0);
#pragma unroll
        for (int kk = 0; kk < 8; ++kk) s0 = __builtin_amdgcn_mfma_f32_32x32x16_bf16(fa[kk], qf[kk], s0, 0, 0, 0);
        __builtin_amdgcn_sched_barrier(0);
#pragma unroll
        for (int kk = 4; kk < 8; ++kk) fb[kk] = *(const LAS bf16x8*)(rp + 32 * 256 + ((32 * kk + hb) ^ sw));
#pragma unroll
        for (int kk = 0; kk < 8; ++kk) s1 = __builtin_amdgcn_mfma_f32_32x32x16_bf16(fb[kk], qf[kk], s1, 0, 0, 0);
    }
    __builtin_amdgcn_sched_barrier(0);
    bf16x8 va0[8], va1[8];
    at_vload(va0, vb, 0, lane); __builtin_amdgcn_sched_barrier(0);
    const bool edge = (MODE == MODE_SEL) ? (j == qb) : (j == qb || j == qb - 8);
    const bool blk = (MODE == MODE_SEL) ? (((mword >> j) & 1u) != 0u) : true;
    if (edge) {
        int thr = tq - (j * 64 + 4 * (lane >> 5)); asm volatile("" : "+v"(thr));
        if (MODE == MODE_SEL && !blk) thr = -1;
#pragma unroll
        for (int i = 0; i < 16; ++i) { const int c = (i & 3) + 8 * (i >> 2);
            bool v0, v1;
            if (MODE == MODE_SEL) { v0 = (c <= thr); v1 = (c + 32 <= thr); }
            else { v0 = (c <= thr) && (c + 512 > thr); v1 = (c + 32 <= thr) && (c + 32 + 512 > thr); }
            s0[i] = v0 ? s0[i] : -__builtin_inff(); s1[i] = v1 ? s1[i] : -__builtin_inff(); }
    }
    float mx = s0[0];
#pragma unroll
    for (int i = 1; i < 16; ++i) mx = fmaxf(mx, s0[i]);
#pragma unroll
    for (int i = 0; i < 16; ++i) mx = fmaxf(mx, s1[i]);
    mx = fmaxf(mx, __shfl_xor(mx, 32));
    const bool dead = (MODE == MODE_SEL) && !edge && !blk;
    mx = dead ? -__builtin_inff() : mx;
    const float mn = fmaxf(m, mx), alpha = __builtin_amdgcn_exp2f(m - mn);
    const float sub = dead ? __builtin_inff() : mn;
    const pg8::f32x2 sv = (pg8::f32x2){sub, sub}; pg8::f32x2 ps2 = (pg8::f32x2){0.f, 0.f};
#pragma unroll
    for (int i = 0; i < 16; i += 2) {
        const pg8::f32x2 a = (pg8::f32x2){s0[i], s0[i + 1]} - sv, b = (pg8::f32x2){s1[i], s1[i + 1]} - sv;
        s0[i] = __builtin_amdgcn_exp2f(a.x); s0[i + 1] = __builtin_amdgcn_exp2f(a.y); s1[i] = __builtin_amdgcn_exp2f(b.x); s1[i + 1] = __builtin_amdgcn_exp2f(b.y);
        ps2 += (pg8::f32x2){s0[i], s0[i + 1]} + (pg8::f32x2){s1[i], s1[i + 1]}; }
    const float ps = ps2.x + ps2.y;
    l = l * alpha + ps; m = mn;
    if (!__all(alpha == 1.0f)) {
#pragma unroll
        for (int dt = 0; dt < 4; ++dt)
#pragma unroll
            for (int i = 0; i < 16; ++i) o[dt][i] *= alpha;
    }
    __builtin_amdgcn_sched_barrier(0);
    at_pv_r<0>(o, va0, s0); __builtin_amdgcn_sched_barrier(0);
    at_vload(va1, vb, 1, lane); __builtin_amdgcn_sched_barrier(0);
    at_pv_r<1>(o, va0, s0); __builtin_amdgcn_sched_barrier(0);
    at_pv_r<0>(o, va1, s1); at_pv_r<1>(o, va1, s1); __builtin_amdgcn_sched_barrier(0);
}
template <int MODE>
__device__ __forceinline__ void at_branch(const bf16x8 (&qf)[8], const bf16* Kb, int pitchK, const bf16* Vb, int pitchV, int jlo, int jhi, int qb, int tq, unsigned mword, const float* gp,
                                          LAS unsigned char* lds, int tid, int lane) {
    f32x16 o[4];
#pragma unroll
    for (int dt = 0; dt < 4; ++dt)
#pragma unroll
        for (int i = 0; i < 16; ++i) o[dt][i] = 0.f;
    float m = -1e30f, l = 0.f;
    v4u krA[2], vrA[2], krB[2], vrB[2];
    at_load(krA, vrA, Kb, pitchK, Vb, pitchV, jlo, tid);
    if (jlo < jhi) at_load(krB, vrB, Kb, pitchK, Vb, pitchV, jlo + 1, tid);
    __syncthreads();
    at_store(krA, vrA, lds, 0, tid);
    __syncthreads();
    for (int j = jlo; ; j += 2) {
        if (j + 2 <= jhi) at_load(krA, vrA, Kb, pitchK, Vb, pitchV, j + 2, tid);
        at_step<MODE>(o, m, l, qf, lds + AT_K0, lds + AT_V0, j, qb, tq, mword, lane);
        if (j + 1 <= jhi) at_store(krB, vrB, lds, 1, tid);
        __syncthreads();
        if (j + 1 > jhi) break;
        if (j + 3 <= jhi) at_load(krB, vrB, Kb, pitchK, Vb, pitchV, j + 3, tid);
        at_step<MODE>(o, m, l, qf, lds + AT_K0 + AT_KB, lds + AT_V0 + AT_VB, j + 1, qb, tq, mword, lane);
        if (j + 2 <= jhi) at_store(krA, vrA, lds, 0, tid);
        __syncthreads();
        if (j + 2 > jhi) break;
    }
    l += __shfl_xor(l, 32);
    const float gate = gp[tq * 48];
    const float f = l > 0.f ? gate / l : 0.f;
    oc_add<false>(lds, tid, o, f);
}
__device__ __forceinline__ void nsa_attention(unsigned char* ws, bf16* XB, LAS unsigned char* lds, int vcu, int G) {
    const bf16* Q = (const bf16*)(ws + WS_MIX + MX_NSA_Q); const float* GT = (const float*)(ws + WS_MIX + MX_NSA_GT);
    for (int idx = vcu; idx < NB * 4 * 32; idx += G) {
        int tid = pg8::tidx(lds); asm volatile("" : "+v"(tid));
        const int lane = tid & 63, w = __builtin_amdgcn_readfirstlane(tid >> 6);
        const int L = idx & 1023, rev = idx >> 10, bg = L >> 4, q16 = L & 15, qb = rev ? 31 - q16 : q16, b = bg >> 2, g = bg & 3;
        const int hq = g * 4 + (w >> 1), tl = (w & 1) * 32 + (lane & 31), tq = qb * 64 + tl; const size_t row = (size_t)b * T + tq;
        bf16x8 qf[8];
#pragma unroll
        for (int kk = 0; kk < 8; ++kk) qf[kk] = *(const bf16x8*)(Q + row * 2048 + hq * 128 + 16 * kk + 8 * (lane >> 5));
        const float g_cmp = GT[row * 48 + hq];
        f32x16 ocmp[4];
#pragma unroll
        for (int dt = 0; dt < 4; ++dt)
#pragma unroll
            for (int i = 0; i < 16; ++i) ocmp[dt][i] = 0.f;
        {
            const bf16* Kb = (const bf16*)(ws + WS_MIX + MX_NSA_KCMP) + (size_t)bg * 128 * 128; const bf16* Vb = (const bf16*)(ws + WS_MIX + MX_NSA_VCMPT) + (size_t)bg * 128 * 128;
            v4u kr[2], vr[2];
            __syncthreads();
            at_load(kr, vr, Kb, 128, Vb, 128, 0, tid); at_store(kr, vr, lds, 0, tid);
            at_load(kr, vr, Kb, 128, Vb, 128, 1, tid); at_store(kr, vr, lds, 1, tid);
            __syncthreads();
            f32x16 s[4];
#pragma unroll
            for (int k4 = 0; k4 < 4; ++k4) s[k4] = at_qk(lds + AT_K0 + (k4 >> 1) * AT_KB, k4 & 1, qf, lane);
            float mx = -1e30f;
            int nthr = ((tq - 31) >> 4) - 4 * (lane >> 5); asm volatile("" : "+v"(nthr));
#pragma unroll
            for (int k4 = 0; k4 < 4; ++k4)
#pragma unroll
                for (int i = 0; i < 16; ++i) { const bool v = (32 * k4 + (i & 3) + 8 * (i >> 2) <= nthr); s[k4][i] = v ? s[k4][i] : -__builtin_inff(); mx = fmaxf(mx, s[k4][i]); }
            mx = fmaxf(mx, __shfl_xor(mx, 32));
            float ps = 0.f;
#pragma unroll
            for (int k4 = 0; k4 < 4; ++k4)
#pragma unroll
                for (int i = 0; i < 16; ++i) { s[k4][i] = __builtin_amdgcn_exp2f(s[k4][i] - mx); ps += s[k4][i]; }
            ps += __shfl_xor(ps, 32);
            const float inv = ps > 0.f ? 1.0f / ps : 0.f;
#pragma unroll
            for (int k4 = 0; k4 < 4; ++k4)
#pragma unroll
                for (int i = 0; i < 16; ++i) s[k4][i] *= inv;
            float q4[16], lastv[16];
#pragma unroll
            for (int k4 = 0; k4 < 4; ++k4)
#pragma unroll
                for (int g4 = 0; g4 < 4; ++g4) { q4[4 * k4 + g4] = (s[k4][4 * g4] + s[k4][4 * g4 + 1]) + (s[k4][4 * g4 + 2] + s[k4][4 * g4 + 3]); lastv[4 * k4 + g4] = s[k4][4 * g4 + 3]; }
            {
                const int h = lane >> 5; LAS float* ip = (LAS float*)(lds + AT_IMP) + ((w >> 1) * 64 + tl) * 32;
                float prev = 0.f;
#pragma unroll
                for (int i = 0; i < 16; ++i) { const float pl = __shfl_xor(lastv[i], 32); const float add = h ? pl : prev; prev = pl; ip[2 * i + h] = q4[i] + add; }
            }
            __builtin_amdgcn_sched_barrier(0);
            f32x16 o[4];
#pragma unroll
            for (int dt = 0; dt < 4; ++dt)
#pragma unroll
                for (int i = 0; i < 16; ++i) o[dt][i] = 0.f;
#pragma unroll
            for (int k4 = 0; k4 < 4; ++k4) { at_pv(o, lds + AT_V0 + (k4 >> 1) * AT_VB, k4 & 1, s[k4], lane); __builtin_amdgcn_sched_barrier(0); }
#pragma unroll
            for (int dt = 0; dt < 4; ++dt) ocmp[dt] = o[dt];
        }
        __syncthreads();
        {
            const int tt = tid >> 3, sub = tid & 7, cur = qb; const LAS float* ip = (const LAS float*)(lds + AT_IMP) + tt * 32;
            float sc[32];
#pragma unroll
            for (int mb = 0; mb < 32; ++mb) { float v = (ip[mb] + ip[64 * 32 + mb]) + (ip[2 * 64 * 32 + mb] + ip[3 * 64 * 32 + mb]);
                const bool forced = (mb == 0) || (mb == cur) || (mb == cur - 1);
                sc[mb] = (mb <= cur) ? (v + (forced ? 1000.f : 0.f)) : -1e30f; }
            unsigned bits = 0u;
#pragma unroll
            for (int k = 0; k < 4; ++k) { const int mb = sub * 4 + k; float mine = sc[0];
#pragma unroll
                for (int q = 1; q < 32; ++q) mine = (q == mb) ? sc[q] : mine;
                int rank = 0;
#pragma unroll
                for (int q = 0; q < 32; ++q) rank += (sc[q] > mine || (sc[q] == mine && q < mb)) ? 1 : 0;
                bits |= (rank < 16 ? 1u : 0u) << mb; }
            bits |= __shfl_xor(bits, 1); bits |= __shfl_xor(bits, 2); bits |= __shfl_xor(bits, 4);
            if (sub == 0) *(LAS unsigned*)(lds + AT_MASK + tt * 4) = bits;
        }
        __syncthreads();
        oc_add<true>(lds, tid, ocmp, g_cmp);
        const unsigned mword = *(const LAS unsigned*)(lds + AT_MASK + tl * 4);
        at_branch<MODE_SEL>(qf, (const bf16*)(ws + WS_MIX + MX_NSA_KS) + (size_t)b * T * 512 + g * 128, 512, (const bf16*)(ws + WS_MIX + MX_NSA_VST) + ((size_t)b * 512 + g * 128) * 2048, 2048,
                            0, qb, qb, tq, mword, GT + (size_t)b * T * 48 + 16 + hq, lds, tid, lane);
        at_branch<MODE_WIN>(qf, (const bf16*)(ws + WS_MIX + MX_NSA_KW) + (size_t)b * T * 512 + g * 128, 512, (const bf16*)(ws + WS_MIX + MX_NSA_VWT) + ((size_t)b * 512 + g * 128) * 2048, 2048,
                            qb > 8 ? qb - 8 : 0, qb, qb, tq, 0u, GT + (size_t)b * T * 48 + 32 + hq, lds, tid, lane);
        {
            bf16* op = XB + row * 2048 + hq * 128 + 4 * (lane >> 5);
#pragma unroll
            for (int dt = 0; dt < 4; ++dt)
#pragma unroll
                for (int g4 = 0; g4 < 4; ++g4) *(v2u*)(op + 32 * dt + 8 * g4) = *(const LAS v2u*)(lds + AT_OC + (dt * 4 + g4) * 4096 + tid * 8);
        }
    }
}
struct Args { const float* in[N_IN]; float* out; unsigned char* ws; };
constexpr int PTAB_OFF = LDSCTL_OFF + 512;
__device__ __forceinline__ unsigned long long ptab_get(LAS unsigned char* lds, int i) {
    int io = 8 * i; asm volatile("" : "+v"(io));
    const volatile LAS unsigned* p = (const volatile LAS unsigned*)(lds + PTAB_OFF + io);
    const unsigned lo = __builtin_amdgcn_readfirstlane(p[0]), hi = __builtin_amdgcn_readfirstlane(p[1]);
    return ((unsigned long long)hi << 32) | lo;
}
__device__ __forceinline__ const float* in_ptr(LAS unsigned char* lds, int i) { return (const float*)(const GAS float*)ptab_get(lds, i); }
__device__ __forceinline__ unsigned char* ws_ptr(LAS unsigned char* lds) { return (unsigned char*)(GAS unsigned char*)ptab_get(lds, N_IN + 1); }
__device__ __forceinline__ float* out_ptr(LAS unsigned char* lds) { return (float*)(GAS float*)ptab_get(lds, N_IN); }
__device__ __forceinline__ float wave_sum(float v) {
#pragma unroll
    for (int o = 1; o < 64; o <<= 1) v += __shfl_xor(v, o);
    return v;
}
enum { KIND_ID = 0, KIND_SWIGLU = 1, KIND_CONV = 2, KIND_NSA = 3 };
__device__ __forceinline__ int src_col0(int kind, int n0) {
    const int tile = n0 >> 8, rem = n0 & 255, bj = rem >> 7, i = rem & 127;
    if (kind == KIND_SWIGLU) return bj * DFF + tile * 128 + i;
    if (kind == KIND_CONV) { if (n0 < 2048) return n0; return 2048 + bj * 2048 + ((n0 - 2048) >> 8) * 128 + i; }
    if (kind == KIND_NSA) { const bool rope = tile < 10 || tile == 12 || tile == 13 || tile == 16 || tile == 17; if (!rope) return n0; return tile * 256 + (i >> 6) * 128 + (i & 63) + 64 * bj; }
    return n0;
}
struct Job { const float* src; bf16* dst; int K, Nsrc, Ndst, kind, ci, lnidx; };
constexpr int NJOBS = 32;
__device__ __forceinline__ Job get_job(LAS unsigned char* lds, int j) {
    unsigned char* ws = ws_ptr(lds); Job J; J.ci = -1; J.lnidx = -1;
    if (j < 8)       { J.src = in_ptr(lds, I_FFN_WIN) + (size_t)j * D * 2 * DFF; J.dst = (bf16*)(ws + WS_FFN_WIN + (size_t)j * SZ_FFN_WIN); J.K = D; J.Nsrc = 2 * DFF; J.Ndst = 2 * DFF; J.kind = KIND_SWIGLU; J.ci = j; J.lnidx = 3 * (j >> 1) + 2 * (j & 1) - 1; }
    else if (j < 16) { const int f = j - 8; J.src = in_ptr(lds, I_FFN_WOUT) + (size_t)f * DFF * D; J.dst = (bf16*)(ws + WS_FFN_WOUT + (size_t)f * SZ_FFN_WOUT); J.K = DFF; J.Nsrc = D; J.Ndst = D; J.kind = KIND_ID; }
    else if (j < 18) { const int f = j - 16; J.src = in_ptr(lds, I_NSA_WIN) + (size_t)f * D * NSA_NSRC; J.dst = (bf16*)(ws + WS_NSA_WIN + (size_t)f * SZ_NSA_WIN); J.K = D; J.Nsrc = NSA_NSRC; J.Ndst = NSA_NPAD; J.kind = KIND_NSA; J.ci = 8 + f; J.lnidx = 9 * f; }
    else if (j < 20) { const int f = j - 18; J.src = in_ptr(lds, I_NSA_WOUT) + (size_t)f * D * D; J.dst = (bf16*)(ws + WS_NSA_WOUT + (size_t)f * SZ_DD); J.K = D; J.Nsrc = D; J.Ndst = D; J.kind = KIND_ID; }
    else if (j == 20) { J.src = in_ptr(lds, I_CONV_WIN); J.dst = (bf16*)(ws + WS_CONV_WIN); J.K = D; J.Nsrc = CONV_N; J.Ndst = CONV_N; J.kind = KIND_CONV; J.ci = 10; J.lnidx = 3; }
    else if (j == 21) { J.src = in_ptr(lds, I_CONV_WOUT); J.dst = (bf16*)(ws + WS_CONV_WOUT); J.K = D; J.Nsrc = D; J.Ndst = D; J.kind = KIND_ID; }
    else if (j == 22) { J.src = in_ptr(lds, I_GLA_WIN); J.dst = (bf16*)(ws + WS_GLA_WIN); J.K = D; J.Nsrc = GLA_NSRC; J.Ndst = GLA_NPAD; J.kind = KIND_ID; J.ci = 11; J.lnidx = 6; }
    else if (j == 23) { J.src = in_ptr(lds, I_GLA_WOUT); J.dst = (bf16*)(ws + WS_GLA_WOUT); J.K = D; J.Nsrc = D; J.Ndst = D; J.kind = KIND_ID; }
    else if (j < 28) { const int f = j - 24; J.src = in_ptr(lds, I_NSA_CW1) + (size_t)f * 4096 * 128; J.dst = (bf16*)(ws + WS_CMP_W1T + (size_t)f * 128 * 4096 * 2); J.K = 4096; J.Nsrc = 128; J.Ndst = 128; J.kind = KIND_ID; }
    else             { const int f = j - 28; J.src = in_ptr(lds, I_NSA_CW2) + (size_t)f * 128 * 128; J.dst = (bf16*)(ws + WS_CMP_W2T + (size_t)f * 128 * 128 * 2); J.K = 128; J.Nsrc = 128; J.Ndst = 128; J.kind = KIND_ID; }
    return J;
}
__device__ __forceinline__ void transpose_item(const Job& J, const float* lg, const float* lb, float* part, LAS float* scr, int item, int lane) {
    const int nblk = J.Ndst >> 6, kb = item / nblk, nb = item - kb * nblk, k0 = 64 * kb, n0 = 64 * nb;
    const int sc = src_col0(J.kind, n0) + lane; const bool ok = sc < J.Nsrc;
    const float* wp = J.src + (size_t)k0 * J.Nsrc + (ok ? sc : 0);
    float v[64];
#pragma unroll
    for (int i = 0; i < 64; ++i) v[i] = wp[(size_t)i * J.Nsrc];
#pragma unroll
    for (int i = 0; i < 64; ++i) scr[i * 65 + lane] = ok ? v[i] : 0.f;
    LDS_WAIT(); asm volatile("" ::: "memory");
    const int c = lane & 7;
    float gk[8], bk[8];
#pragma unroll
    for (int i = 0; i < 8; ++i) { gk[i] = 1.f; bk[i] = 0.f; }
    if (J.ci >= 0 && J.lnidx >= 0) {
#pragma unroll
        for (int i = 0; i < 8; ++i) { gk[i] = lg[k0 + 8 * c + i]; bk[i] = lb[k0 + 8 * c + i]; } }
#pragma unroll
    for (int j = 0; j < 8; ++j) { const int n = (lane >> 3) + 8 * j; const LAS float* s = scr + (8 * c) * 65 + n;
        float w[8];
#pragma unroll
        for (int i = 0; i < 8; ++i) w[i] = s[i * 65];
        v4u o;
        if (J.ci >= 0) { o.x = pg8::cvt_pk_f16(w[0] * gk[0], w[1] * gk[1]); o.y = pg8::cvt_pk_f16(w[2] * gk[2], w[3] * gk[3]); o.z = pg8::cvt_pk_f16(w[4] * gk[4], w[5] * gk[5]); o.w = pg8::cvt_pk_f16(w[6] * gk[6], w[7] * gk[7]); }
        else { o.x = pk2(w[0], w[1]); o.y = pk2(w[2], w[3]); o.z = pk2(w[4], w[5]); o.w = pk2(w[6], w[7]); }
        *(v4u*)(J.dst + (size_t)(n0 + n) * J.K + k0 + 8 * c) = o;
        if (J.ci >= 0) {
            const pg8::f32x2_t u0 = pg8::unpk_f16(o.x), u1 = pg8::unpk_f16(o.y), u2 = pg8::unpk_f16(o.z), u3 = pg8::unpk_f16(o.w);
            float cs = ((u0[0] + u0[1]) + (u1[0] + u1[1])) + ((u2[0] + u2[1]) + (u3[0] + u3[1]));
            float bs = ((w[0] * bk[0] + w[1] * bk[1]) + (w[2] * bk[2] + w[3] * bk[3])) + ((w[4] * bk[4] + w[5] * bk[5]) + (w[6] * bk[6] + w[7] * bk[7]));
            cs += __shfl_xor(cs, 1); bs += __shfl_xor(bs, 1); cs += __shfl_xor(cs, 2); bs += __shfl_xor(bs, 2); cs += __shfl_xor(cs, 4); bs += __shfl_xor(bs, 4);
            if (c == 0) { part[(size_t)kb * 16384 + n0 + n] = cs; part[(size_t)(32 + kb) * 16384 + n0 + n] = bs; }
        } }
    LDS_WAIT(); asm volatile("" ::: "memory");
}
__device__ __forceinline__ void conv_phase(const bf16* BG, const bf16* U, const float* cw, bf16* out, int vcu, int NT, const LAS unsigned char* lds) {
    int gtid = pg8::tidx(lds); asm volatile("" : "+v"(gtid)); gtid += vcu * (NWAVES * 64);
    for (int idx = gtid; idx < M * 256; idx += NT) {
        const int m = idx >> 8, col = (idx & 255) * 8, t = m & (T - 1);
        const v4u u0 = *(const v4u*)(U + (size_t)m * D + col);
        v4u u1 = (v4u){0u, 0u, 0u, 0u}, u2 = (v4u){0u, 0u, 0u, 0u};
        if (t >= 1) u1 = *(const v4u*)(U + (size_t)(m - 1) * D + col);
        if (t >= 2) u2 = *(const v4u*)(U + (size_t)(m - 2) * D + col);
        const v4u bg = *(const v4u*)(BG + (size_t)m * D + col);
        const f32x4 w0a = *(const f32x4*)(cw + col), w0b = *(const f32x4*)(cw + col + 4), w1a = *(const f32x4*)(cw + D + col), w1b = *(const f32x4*)(cw + D + col + 4),
                    w2a = *(const f32x4*)(cw + 2 * D + col), w2b = *(const f32x4*)(cw + 2 * D + col + 4);
        float y[8];
#pragma unroll
        for (int p = 0; p < 4; ++p) {
            const float wl0 = p < 2 ? w0a[2 * p] : w0b[2 * p - 4], wh0 = p < 2 ? w0a[2 * p + 1] : w0b[2 * p - 3];
            const float wl1 = p < 2 ? w1a[2 * p] : w1b[2 * p - 4], wh1 = p < 2 ? w1a[2 * p + 1] : w1b[2 * p - 3];
            const float wl2 = p < 2 ? w2a[2 * p] : w2b[2 * p - 4], wh2 = p < 2 ? w2a[2 * p + 1] : w2b[2 * p - 3];
            y[2 * p]     = bf_lo(bg[p]) * (wl0 * bf_lo(u2[p]) + wl1 * bf_lo(u1[p]) + wl2 * bf_lo(u0[p]));
            y[2 * p + 1] = bf_hi(bg[p]) * (wh0 * bf_hi(u2[p]) + wh1 * bf_hi(u1[p]) + wh2 * bf_hi(u0[p]));
        }
        v4u o; o.x = pk2(y[0], y[1]); o.y = pk2(y[2], y[3]); o.z = pk2(y[4], y[5]); o.w = pk2(y[6], y[7]);
        *(v4u*)(out + (size_t)m * D + col) = o;
    }
}

__device__ const double ROPE_INV[64] = {1.0, 0.8659643233600653, 0.7498942093324559, 0.6493816315762113, 0.5623413251903491, 0.4869675251658631, 0.4216965034285822, 0.3651741272548377, 0.31622776601683794, 0.27384196342643613, 0.23713737056616552, 0.2053525026457146, 0.1778279410038923, 0.1539926526059492, 0.1333521432163324, 0.11547819846894582, 0.1, 0.08659643233600653, 0.07498942093324558, 0.06493816315762113, 0.05623413251903491, 0.04869675251658631, 0.042169650342858224, 0.03651741272548377, 0.03162277660168379, 0.027384196342643614, 0.023713737056616554, 0.02053525026457146, 0.01778279410038923, 0.01539926526059492, 0.01333521432163324, 0.011547819846894581, 0.01, 0.008659643233600654, 0.007498942093324558, 0.006493816315762113, 0.005623413251903491, 0.004869675251658631, 0.004216965034285823, 0.003651741272548377, 0.0031622776601683794, 0.0027384196342643613, 0.0023713737056616554, 0.002053525026457146, 0.0017782794100389228, 0.001539926526059492, 0.001333521432163324, 0.0011547819846894581, 0.001, 0.0008659643233600654, 0.0007498942093324559, 0.0006493816315762113, 0.0005623413251903491, 0.0004869675251658631, 0.00042169650342858224, 0.0003651741272548377, 0.00031622776601683794, 0.0002738419634264361, 0.00023713737056616554, 0.0002053525026457146, 0.00017782794100389227, 0.0001539926526059492, 0.0001333521432163324, 0.00011547819846894582};
#ifndef RESID_WGM
#define RESID_WGM 4
#endif
__global__ void __launch_bounds__(NWAVES * 64, 2) mk_fwd(Args args) {
    extern __shared__ __attribute__((aligned(16))) unsigned char lds_raw[];
    LAS unsigned char* lds = (LAS unsigned char*)lds_raw;
    volatile LAS unsigned* MISC = (volatile LAS unsigned*)(lds + MISC_OFF);
    const int tid = threadIdx.x, lane = tid & 63, wave = __builtin_amdgcn_readfirstlane(tid >> 6);
    const int G = gridDim.x; const int bx = blockIdx.x; const int vcu = (G % 8 == 0) ? (bx % 8) * (G / 8) + bx / 8 : bx;
    const int gw = vcu * NWAVES + wave, NGW = G * NWAVES, gtid = vcu * (NWAVES * 64) + tid, NT = G * NWAVES * 64;
    for (int u = tid; u < (LDS_BYTES - LDSCTL_OFF) / 4; u += NWAVES * 64) ((LAS unsigned*)(lds + LDSCTL_OFF))[u] = 0u;
    __syncthreads();
    if (tid < 2 * (N_IN + 2)) ((LAS unsigned*)(lds + PTAB_OFF))[tid] = ((const unsigned*)&args)[tid];
    if (lane == 0) ((LAS int*)(lds + pg8::WIDTAB_BYTE))[pg8::hw_wave_slot()] = wave;
    __syncthreads();
    if (pg8::wave_idx(lds) != wave) __builtin_trap();
    unsigned* ctl = (unsigned*)(ws_ptr(lds) + WS_CTL);
    XcdBarrier bar = xcd_barrier_post(ctl + CW_BAR, MISC + 8);


    {
        unsigned char* ws = ws_ptr(lds); bf16* XB = (bf16*)(ws + WS_XB);
        LAS float* scr = (LAS float*)(lds + RING_OFF + wave * 16896);
        int g = gw;
        for (int j = 0; j < NJOBS; ++j) {
            const Job J = get_job(lds, j); const int items = (J.K >> 6) * (J.Ndst >> 6);
            const float* lg = in_ptr(lds, I_LNG) + (size_t)(J.lnidx > 0 ? J.lnidx : 0) * D; const float* lb = in_ptr(lds, I_LNB) + (size_t)(J.lnidx > 0 ? J.lnidx : 0) * D;
            float* part = (float*)(ws + WS_PART) + (size_t)(J.ci > 0 ? J.ci : 0) * (2 * 32 * 16384);
            while (g < items) { transpose_item(J, lg, lb, part, scr, g, lane); g += NGW; }
            g -= items;
        }
        {
            const int* pos = (const int*)in_ptr(lds, I_POS); float* cosT = (float*)(ws + WS_COS); float* sinT = (float*)(ws + WS_SIN);
            for (int idx = gtid; idx < M * 64; idx += NT) { const int m = idx >> 6, dd = idx & 63; const double rev = (double)pos[m] * ROPE_INV[dd] * 0.15915494309189535; const float fr = (float)(rev - __builtin_rint(rev));
                cosT[idx] = __builtin_amdgcn_cosf(fr); sinT[idx] = __builtin_amdgcn_sinf(fr); }
        }
        for (int i = gtid; i < M; i += NT) *(pg8::f32x2*)((float*)(ws + WS_RS) + 2 * (size_t)i) = (pg8::f32x2){0.f, 1.f};
        if (gtid < 2048) { ((float*)(ws + WS_MISC + 8192))[gtid] = 1.f; ((float*)(ws + WS_MISC + 8192 + 8192))[gtid] = 0.f; }
        if (gw < 512) {
            const int f = gw >> 7, j = gw & 127; const float* cp = in_ptr(lds, I_NSA_CPOS) + (size_t)f * 4096; const float* w1 = in_ptr(lds, I_NSA_CW1) + (size_t)f * 4096 * 128; float sacc = 0.f;
            for (int i = 0; i < 64; ++i) { const int k = lane + 64 * i; sacc += cp[k] * w1[(size_t)k * 128 + j]; }
            sacc = wave_sum(sacc); if (lane == 0) ((float*)(ws + WS_MISC))[f * 128 + j] = sacc;
        }
        const float* x = in_ptr(lds, I_X);
        for (int idx = gtid; idx < M * (D / 8); idx += NT) { const f32x4 a = *(const f32x4*)(x + (size_t)idx * 8), b = *(const f32x4*)(x + (size_t)idx * 8 + 4);
            v4u o; o.x = pg8::cvt_pk_f16(a.x, a.y); o.y = pg8::cvt_pk_f16(a.z, a.w); o.z = pg8::cvt_pk_f16(b.x, b.y); o.w = pg8::cvt_pk_f16(b.z, b.w); *(v4u*)(XB + (size_t)idx * 8) = o; }
    }
    xcd_barrier(bar);
    {
        unsigned char* ws = ws_ptr(lds); const float* part = (const float*)(ws + WS_PART); float* csbv = (float*)(ws + WS_CSBV);
        for (int idx = gtid; idx < 12 * 2 * 16384; idx += NT) { const int ci = idx >> 15, which = (idx >> 14) & 1, n = idx & 16383;
            const float* p = part + (size_t)ci * (2 * 32 * 16384) + (size_t)which * 32 * 16384 + n; float a = 0.f;
#pragma unroll 8
            for (int kb = 0; kb < 32; ++kb) a += p[(size_t)kb * 16384];
            csbv[(size_t)(which * 12 + ci) * 16384 + n] = a; }
    }
    xcd_barrier(bar);

    for (int s = 0; s < 3 * DEPTH; ++s) {
        const int layer = s / 3, which = s - 3 * layer, kind = layer % 3, mj = layer / 3;
        unsigned char* ws = ws_ptr(lds); bf16* XB = (bf16*)(ws + WS_XB); float* XF = out_ptr(lds); bf16* HB = (bf16*)(ws + WS_MIX);
        const float* xin = (s == 0) ? in_ptr(lds, I_X) : (const float*)XF;
        bf16* A2 = (bf16*)(ws + WS_A2);
        float* pscur = (float*)(ws + WS_PS);
        const int ci = (which != 1) ? layer * 2 + (which >> 1) : (kind == 0 ? 8 + mj : (kind == 1 ? 10 : 11));
        const float* fcs = (const float*)(ws + WS_CSBV) + (size_t)ci * 16384; const float* fbv = (const float*)(ws + WS_CSBV) + (size_t)(12 + ci) * 16384;
#define FIX pg8::LnFix{fcs, fbv, (const float*)(ws + WS_RS), lds + RING_OFF + 131072}
        const bf16* rA; const bf16* rW; int rK; float rscale;
        if (which != 1) {
            const int f = layer * 2 + (which >> 1);
            {
                pg8::Gemm g{XB, (const bf16*)(ws + WS_FFN_WIN + (size_t)f * SZ_FFN_WIN), M, 2 * DFF, D}; pg8::StaticOrder S; S.init(M, 2 * DFF, G, bx);
                pg8::EpiSwiglu E{HB, DFF, FIX};
                pg8::gemm_phase<pg8::EpiSwiglu, pg8::StaticOrder, PG8_ALIGN, PG8_SP2, true>(lds + RING_OFF, g, S, E);
            }
            xcd_barrier(bar);
            rA = HB; rW = (const bf16*)(ws + WS_FFN_WOUT + (size_t)f * SZ_FFN_WOUT); rK = DFF; rscale = 0.5f;
        } else if (kind == 1) {
            {
                pg8::Gemm g{XB, (const bf16*)(ws + WS_CONV_WIN), M, CONV_N, D}; pg8::StaticOrder S; S.init(M, CONV_N, G, bx);
                pg8::EpiConvIn E{(bf16*)(ws + WS_MIX + MX_CONV_BG), (bf16*)(ws + WS_MIX + MX_CONV_U), FIX};
                pg8::gemm_phase<pg8::EpiConvIn, pg8::StaticOrder, PG8_ALIGN, PG8_SP2, true>(lds + RING_OFF, g, S, E);
            }
            xcd_barrier(bar);
            conv_phase((const bf16*)(ws + WS_MIX + MX_CONV_BG), (const bf16*)(ws + WS_MIX + MX_CONV_U), in_ptr(lds, I_CONV_W) + (size_t)mj * 3 * D, A2, vcu, NT, lds);
            xcd_barrier(bar);
            rA = A2; rW = (const bf16*)(ws + WS_CONV_WOUT); rK = D; rscale = 1.0f;
        } else if (kind == 2) {
            {
                pg8::Gemm g{XB, (const bf16*)(ws + WS_GLA_WIN), M, GLA_NPAD, D}; pg8::StaticOrder S; S.init(M, GLA_NPAD, G, bx);
                pg8::EpiGlaIn E{ws + WS_MIX, FIX};
                pg8::gemm_phase<pg8::EpiGlaIn, pg8::StaticOrder, PG8_ALIGN, PG8_SP2, true>(lds + RING_OFF, g, S, E);
            }
            xcd_barrier(bar);
            gla_prep(ws, in_ptr(lds, I_GLA_WA2) + (size_t)mj * 16 * 1024, in_ptr(lds, I_GLA_BA) + (size_t)mj * 1024, lds, vcu, G);
            xcd_barrier(bar);
            gla_scan(ws, lds, vcu, G);
            xcd_barrier(bar);
            gla_out(ws, in_ptr(lds, I_GLA_NG) + (size_t)mj * 512, A2, vcu, NT, lds);
            xcd_barrier(bar);
            rA = A2; rW = (const bf16*)(ws + WS_GLA_WOUT); rK = D; rscale = 1.0f;
        } else {
            {
                pg8::Gemm g{XB, (const bf16*)(ws + WS_NSA_WIN + (size_t)mj * SZ_NSA_WIN), M, NSA_NPAD, D}; pg8::StaticOrder S; S.init(M, NSA_NPAD, G, bx);
                pg8::EpiNsaIn E{ws + WS_MIX, (const float*)(ws + WS_COS), (const float*)(ws + WS_SIN), in_ptr(lds, I_NSA_GB) + (size_t)mj * 48, NSA_QSCALE, FIX};
                pg8::gemm_phase<pg8::EpiNsaIn, pg8::StaticOrder, PG8_ALIGN, PG8_SP2, true>(lds + RING_OFF, g, S, E);
            }
            xcd_barrier(bar);
            nsa_compress(ws, mj, lds, vcu, G);
            xcd_barrier(bar);
            nsa_attention(ws, A2, lds, vcu, G);
            xcd_barrier(bar);
            rA = A2; rW = (const bf16*)(ws + WS_NSA_WOUT + (size_t)mj * SZ_DD); rK = D; rscale = 1.0f;
        }
        {
            pg8::Gemm g{rA, rW, M, D, rK}; pg8::StaticOrder S; S.init(M, D, G, bx, RESID_WGM);
            const int lnp = s > 0 ? s - 1 : 0;
            const float* rg = s > 0 ? in_ptr(lds, I_LNG) + (size_t)lnp * D : (const float*)(ws + WS_MISC + 8192);
            const float* rb = s > 0 ? in_ptr(lds, I_LNB) + (size_t)lnp * D : (const float*)(ws + WS_MISC + 8192 + 8192);
            pg8::EpiResid E{(float*)nullptr, XB, pscur, rscale, rg, rb, (const float*)(ws + WS_RS), lds + RING_OFF + 131072};
            pg8::gemm_phase<pg8::EpiResid, pg8::StaticOrder, PG8_ALIGN, PG8_SP2>(lds + RING_OFF, g, S, E);
        }
        xcd_barrier(bar);
        {
            const float* part = (const float*)(ws + WS_PS); float* rsw = (float*)(ws + WS_RS);
            int t2 = pg8::tidx(lds); asm volatile("" : "+v"(t2));
            for (int i = vcu * 512 + t2; i < M * 2; i += NT) { const int row = i >> 1, half = i & 1; const f32x4* p = (const f32x4*)(part + ((size_t)row * 64 + half * 32));
                float sm = 0.f, sq = 0.f;
#pragma unroll
                for (int k = 0; k < 8; ++k) { const f32x4 v = p[k]; sm += v[0] + v[2]; sq += v[1] + v[3]; }
                sm += __shfl_xor(sm, 1); sq += __shfl_xor(sq, 1);
                const float mean = sm * (1.f / 2048.f), var = sq * (1.f / 2048.f) - mean * mean;
                if (half == 0) *(pg8::f32x2*)(rsw + 2 * (size_t)row) = (pg8::f32x2){mean, 1.f / sqrtf(var + LN_EPS)}; }
            xcd_barrier(bar);
        }
        if (s == 3 * DEPTH - 1) {
            const float* rsf = (const float*)(ws + WS_RS); const float* gf = in_ptr(lds, I_LNG) + (size_t)s * D; const float* bfp = in_ptr(lds, I_LNB) + (size_t)s * D;
            int t3 = pg8::tidx(lds); asm volatile("" : "+v"(t3));
            for (int i = vcu * 512 + t3; i < M * (D / 8); i += NT) { const int row = i >> 8, col = (i & 255) * 8;
                const v4u zw = *(const v4u*)(XB + (size_t)row * D + col); const pg8::f32x2 st = *(const pg8::f32x2*)(rsf + 2 * (size_t)row);
                const pg8::f32x2_t h0 = pg8::unpk_f16(zw.x), h1 = pg8::unpk_f16(zw.y), h2 = pg8::unpk_f16(zw.z), h3 = pg8::unpk_f16(zw.w);
                const f32x4 x0 = (f32x4){h0[0], h0[1], h1[0], h1[1]}, x1 = (f32x4){h2[0], h2[1], h3[0], h3[1]};
                const f32x4 g0 = *(const f32x4*)(gf + col), g1 = *(const f32x4*)(gf + col + 4), b0 = *(const f32x4*)(bfp + col), b1 = *(const f32x4*)(bfp + col + 4);
                *(f32x4*)(XF + (size_t)row * D + col) = (x0 - st.x) * st.y * g0 + b0; *(f32x4*)(XF + (size_t)row * D + col + 4) = (x1 - st.x) * st.y * g1 + b1; }
        }
    }
}

extern "C" void kernel_launch(void* const* d_in, const int* in_sizes, int n_in, void* d_out, int out_size, void* d_ws, size_t ws_size, hipStream_t stream) {
    static int grid = 0;
    if (grid == 0) {
        if (n_in != N_IN || in_sizes[0] != M * D || out_size != M * D || ws_size < WS_END) { fprintf(stderr, "kernel_launch: unexpected shapes (n_in %d, in0 %d, out %d, ws %zu need %zu)\n", n_in, n_in > 0 ? in_sizes[0] : -1, out_size, ws_size, (size_t)WS_END); grid = -1; return; }
        int dev = 0, cus = 0, per_cu = 0;
        if (hipGetDevice(&dev) != hipSuccess || hipDeviceGetAttribute(&cus, hipDeviceAttributeMultiprocessorCount, dev) != hipSuccess) { grid = -1; return; }
        if (hipFuncSetAttribute((const void*)mk_fwd, hipFuncAttributeMaxDynamicSharedMemorySize, LDS_BYTES) != hipSuccess) { fprintf(stderr, "kernel_launch: hipFuncSetAttribute failed\n"); grid = -1; return; }
        if (hipOccupancyMaxActiveBlocksPerMultiprocessor(&per_cu, (const void*)mk_fwd, NWAVES * 64, LDS_BYTES) != hipSuccess || per_cu < 1) { fprintf(stderr, "kernel_launch: occupancy query says %d\n", per_cu); }
        (void)hipGetLastError();
        grid = cus;
    }
    if (grid < 0) return;
    if (hipMemsetAsync((char*)d_ws + WS_CTL, 0, CTL_ZERO_BYTES, stream) != hipSuccess) return;
    Args a{};
    for (int i = 0; i < N_IN; ++i) a.in[i] = (const float*)d_in[i];
    a.out = (float*)d_out; a.ws = (unsigned char*)d_ws;
    hipLaunchKernelGGL(mk_fwd, dim3(grid), dim3(NWAVES * 64), LDS_BYTES, stream, a);
}
```

```cpp
#include <hip/hip_runtime.h>
#include <cstdio>
#include <cstdint>
constexpr size_t MiB = 1u << 20;
constexpr size_t MX_CONV_BG = 0, MX_CONV_U = 128 * MiB;
constexpr size_t MX_GLA_Q = 0, MX_GLA_K = 64 * MiB, MX_GLA_VT = 128 * MiB, MX_GLA_R = 256 * MiB, MX_GLA_KLT = 384 * MiB, MX_GLA_O = 448 * MiB,
                 MX_GLA_A = 576 * MiB, MX_GLA_DEC = 578 * MiB, MX_GLA_SSQ = 580 * MiB;
constexpr size_t MX_NSA_Q = 0, MX_NSA_KC = 128 * MiB, MX_NSA_VC = 160 * MiB, MX_NSA_KS = 192 * MiB, MX_NSA_VST = 224 * MiB, MX_NSA_KW = 256 * MiB, MX_NSA_VWT = 288 * MiB,
                 MX_NSA_GT = 320 * MiB, MX_NSA_KCMP = 328 * MiB, MX_NSA_VCMPT = 330 * MiB;
namespace pg8 {
#define PG8_LAS __attribute__((address_space(3)))
constexpr int WIDTAB_BYTE = 144896 + 1024;
__device__ __forceinline__ unsigned hw_wave_slot() { return (unsigned)__builtin_amdgcn_s_getreg((5 << 11) | 4) & 63u; }
__device__ __forceinline__ int wave_idx(const PG8_LAS unsigned char* lds0) { return __builtin_amdgcn_readfirstlane(*(const volatile PG8_LAS int*)(lds0 + WIDTAB_BYTE + hw_wave_slot() * 4)); }
__device__ __forceinline__ int lane_idx() { unsigned z = 0u; asm volatile("" : "+v"(z)); return (int)__builtin_amdgcn_mbcnt_hi(~0u, __builtin_amdgcn_mbcnt_lo(~0u, z)); }
__device__ __forceinline__ int tidx(const PG8_LAS unsigned char* lds0) { return wave_idx(lds0) * 64 + lane_idx(); }
typedef unsigned short bf16_t;
typedef short bf16x8 __attribute__((ext_vector_type(8)));
typedef float f32x4 __attribute__((ext_vector_type(4)));
typedef unsigned u32x4 __attribute__((ext_vector_type(4)));
constexpr int BM = 256, BK = 64, HALF = 128, HTB = HALF * BK * 2  , STAGE_BYTES = 8 * HTB, NXCD = 8, WGM = 8;

__host__ __device__ __forceinline__ int lds_byte(int r, int c) { const int st = (r >> 4) * 2 + (c >> 5), rr = r & 15, cc = c & 31, ob = rr * 64 + cc * 2; return st * 1024 + (ob ^ (((ob >> 9) & 1) << 5)); }
__host__ __device__ __forceinline__ void stage_rc(int b, int& R, int& C) { const int st = b / 1024, sb = b % 1024, swz = sb ^ (((sb >> 9) & 1) << 5); R = (st >> 1) * 16 + swz / 64; C = (st & 1) * 32 + (swz % 64) / 2; }
__host__ __device__ __forceinline__ int perm32(int rho) { const int n = rho >> 4, i = rho & 15; return 8 * (i >> 2) + 4 * n + (i & 3); }

struct Unit { int pm, pn, par; };
struct Gemm { const bf16_t* A; const bf16_t* Bt; int M, N, K; };

struct StaticOrder {
    int nM, nN, nwg, G, c, wgm;
    __host__ __device__ void init(int M, int N, int G_, int c_, int wgm_ = WGM) { nM = M / BM; nN = N / BM; nwg = nM * nN; G = G_; c = c_; wgm = wgm_; }
    __host__ __device__ bool next(int i, Unit& u) const {
        const long L = (long)i * G + c; if (L >= nwg) return false;
        int wgid = (int)L; { const int q = nwg / NXCD, r = nwg % NXCD, xcd = wgid % NXCD, off = wgid / NXCD; wgid = (xcd < r ? xcd * (q + 1) : r * (q + 1) + (xcd - r) * q) + off; }
        const int nig = wgm * nN, gid = wgid / nig, fm = gid * wgm, gsz = (nM - fm) < wgm ? (nM - fm) : wgm;
        u.pm = fm + ((wgid % nig) % gsz); u.pn = (wgid % nig) / gsz; u.par = i & 1; return true;
    }
    __device__ __forceinline__ void a_ready(const Unit&) const {}
    __device__ __forceinline__ void done(const Unit&) const {}
};
typedef float f32x2_t __attribute__((ext_vector_type(2))); typedef __bf16 bf16x2_t __attribute__((ext_vector_type(2)));
__device__ __forceinline__ unsigned cvt_pk_bf16(float lo, float hi) { f32x2_t v = {lo, hi}; bf16x2_t b = __builtin_convertvector(v, bf16x2_t); return __builtin_bit_cast(unsigned, b); }
typedef float f32x2 __attribute__((ext_vector_type(2)));
typedef _Float16 f16x2_t __attribute__((ext_vector_type(2))); typedef _Float16 f16x8_t __attribute__((ext_vector_type(8)));
__device__ __forceinline__ unsigned cvt_pk_f16(float lo, float hi) { f32x2_t v = {lo, hi}; f16x2_t b = __builtin_convertvector(v, f16x2_t); return __builtin_bit_cast(unsigned, b); }
__device__ __forceinline__ f32x2_t unpk_f16(unsigned w) { return __builtin_convertvector(__builtin_bit_cast(f16x2_t, w), f32x2_t); }
template <bool F16> __device__ __forceinline__ f32x4 mma_sel(const bf16x8& a, const bf16x8& b, const f32x4& c) {
    if constexpr (F16) return __builtin_amdgcn_mfma_f32_16x16x32_f16(__builtin_bit_cast(f16x8_t, a), __builtin_bit_cast(f16x8_t, b), c, 0, 0, 0);
    else return __builtin_amdgcn_mfma_f32_16x16x32_bf16(a, b, c, 0, 0, 0);
}
typedef unsigned u32x2 __attribute__((ext_vector_type(2)));
__device__ __forceinline__ float silu_f(float x) { return x * __builtin_amdgcn_rcpf(1.0f + __expf(-x)); }
__device__ __forceinline__ float sigmoid_f(float x) { return __builtin_amdgcn_rcpf(1.0f + __expf(-x)); }
__device__ __forceinline__ u32x4 pack8(const f32x4 a, const f32x4 b) { u32x4 w; w.x = cvt_pk_bf16(a[0], a[1]); w.y = cvt_pk_bf16(a[2], a[3]); w.z = cvt_pk_bf16(b[0], b[1]); w.w = cvt_pk_bf16(b[2], b[3]); return w; }
__device__ __forceinline__ unsigned short bf16_1(float x) { return (unsigned short)(cvt_pk_bf16(x, 0.f) & 0xffffu); }

constexpr int STAT_TAB_OFF = 131072;
struct LnFix { const float* cs; const float* bv; const float* rs; PG8_LAS unsigned char* aux; };
template <bool PERM>
__device__ __forceinline__ void apply_lnfix(const LnFix& F, f32x4 (&acc)[2][2][4][2], const Unit& u, int wr, int wc, int fr, int fq) {
    asm volatile("" : "+v"(fr), "+v"(fq));
    f32x2 st[2][4];
#pragma unroll
    for (int ai = 0; ai < 2; ++ai)
#pragma unroll
        for (int m = 0; m < 4; ++m) st[ai][m] = *(const PG8_LAS f32x2*)(F.aux + (ai * HALF + wr * 64 + m * 16 + fr) * 8);
#pragma unroll
    for (int bj = 0; bj < 2; ++bj)
#pragma unroll
        for (int n = 0; n < 2; ++n) { const int c = bj * HALF + wc * 32 + (PERM ? 8 * fq + 4 * n : 16 * n + 4 * fq);
            const f32x4 cs = *(const PG8_LAS f32x4*)(F.aux + 2048 + c * 4), bv = *(const PG8_LAS f32x4*)(F.aux + 3072 + c * 4);
#pragma unroll
            for (int ai = 0; ai < 2; ++ai)
#pragma unroll
                for (int m = 0; m < 4; ++m) acc[ai][bj][m][n] = (acc[ai][bj][m][n] - cs * st[ai][m].x) * st[ai][m].y + bv; }
}
__device__ __forceinline__ void stage_lnfix(const LnFix& F, const Unit& u, int tid, int wid) {
    asm volatile("" : "+v"(tid));
    const char* b0 = (const char*)(F.rs + (size_t)u.pm * (2 * BM)); const char* b1 = (const char*)((wid < 4 ? F.cs : F.bv) + u.pn * BM);
    const unsigned o0 = (unsigned)tid * 4u, o1 = (unsigned)(tid & 255) * 4u;
    __builtin_amdgcn_global_load_lds((const unsigned*)(b0 + o0), (PG8_LAS unsigned*)(F.aux + wid * 256), 4, 0, 0);
    __builtin_amdgcn_global_load_lds((const unsigned*)(b1 + o1), (PG8_LAS unsigned*)(F.aux + 2048 + wid * 256), 4, 0, 0);
}
#define LNFIX_TOP() do { apply_lnfix<PERM>(fix, const_cast<f32x4 (&)[2][2][4][2]>(acc), u, wr, wc, fr, fq); } while (0)
struct EpiSwiglu {
    static constexpr bool PERM = true, AFTER_DRAIN = false;
    bf16_t* H; int ldh; LnFix fix;
    __device__ __forceinline__ void operator()(const f32x4 (&acc)[2][2][4][2], const Unit& u, int wr, int wc, int fr, int fq) const {
        LNFIX_TOP();
        const int row0 = u.pm * BM + wr * 64 + fr, col0 = u.pn * HALF + wc * 32 + 8 * fq;
#pragma unroll
        for (int ai = 0; ai < 2; ++ai)
#pragma unroll
            for (int m = 0; m < 4; ++m) { bf16_t* rowp = H + (size_t)(row0 + ai * HALF + m * 16) * ldh + col0;
                f32x4 h0, h1;
#pragma unroll
                for (int e = 0; e < 4; ++e) { h0[e] = silu_f(acc[ai][0][m][0][e]) * acc[ai][1][m][0][e]; h1[e] = silu_f(acc[ai][0][m][1][e]) * acc[ai][1][m][1][e]; }
                *(u32x4*)rowp = pack8(h0, h1); }
    }
};
struct EpiResid {
    static constexpr bool PERM = true, AFTER_DRAIN = false;
    float* out; bf16_t* zb; float* ps; float scale; const float* g; const float* b; const float* rs; PG8_LAS unsigned char* aux;
    static constexpr float alpha = 1.6817928305074292f; static constexpr int ld = 2048;
    __device__ __forceinline__ void operator()(const f32x4 (&acc)[2][2][4][2], const Unit& u, int wr, int wc, int fr, int fq) const {
        asm volatile("" : "+v"(fr), "+v"(fq));
        float sc = scale; asm volatile("" : "+v"(sc));
        const int row0 = u.pm * BM + wr * 64 + fr, col0 = u.pn * BM + wc * 32 + 8 * fq;
        unsigned char* zbase = (unsigned char*)(zb + (size_t)u.pm * BM * ld + u.pn * BM);
        const unsigned zo = (unsigned)(((wr * 64 + fr) * ld + wc * 32 + 8 * fq) * 2);
        f32x2 sta[2][4];
#pragma unroll
        for (int ai = 0; ai < 2; ++ai)
#pragma unroll
            for (int m = 0; m < 4; ++m) sta[ai][m] = *(const PG8_LAS f32x2*)(aux + (ai * HALF + wr * 64 + m * 16 + fr) * 8);
        u32x4 xw[4];
#pragma unroll
        for (int m = 0; m < 4; ++m) xw[m] = *(const u32x4*)(zbase + (zo + (unsigned)((m * 16 * ld) * 2)));
#pragma unroll
        for (int ai = 0; ai < 2; ++ai) {
            f32x2 st[4]; float rsum[4], rsq[4];
#pragma unroll
            for (int m = 0; m < 4; ++m) { rsum[m] = 0.f; rsq[m] = 0.f; }
#pragma unroll
            for (int bj = 0; bj < 2; ++bj) { const int c = col0 + bj * HALF;
                const int cl = (bj * HALF + wc * 32 + 8 * fq) * 4;
                const f32x4 g0 = *(const PG8_LAS f32x4*)(aux + 2048 + cl), g1 = *(const PG8_LAS f32x4*)(aux + 2048 + cl + 16), b0 = *(const PG8_LAS f32x4*)(aux + 3072 + cl) * alpha, b1 = *(const PG8_LAS f32x4*)(aux + 3072 + cl + 16) * alpha;
                u32x4 xn[4];
                { const int k1 = ai * 2 + bj + 1, ai1 = k1 >> 1, bj1 = k1 & 1;
                  if (k1 < 4) {
#pragma unroll
                    for (int m = 0; m < 4; ++m) xn[m] = *(const u32x4*)(zbase + (zo + (unsigned)(((ai1 * HALF + m * 16) * ld + bj1 * HALF) * 2))); } }
                if (bj == 0) {
#pragma unroll
                    for (int m = 0; m < 4; ++m) { st[m] = sta[ai][m]; st[m].y *= alpha; st[m].x *= -st[m].y; } }
#pragma unroll
                for (int m = 0; m < 4; ++m) { const unsigned off = zo + (unsigned)(((ai * HALF + m * 16) * ld + bj * HALF) * 2);
                    const unsigned wx = xw[m].x, wy = xw[m].y, wz = xw[m].z, ww = xw[m].w;
                    const f16x2_t q0 = __builtin_bit_cast(f16x2_t, wx), q1 = __builtin_bit_cast(f16x2_t, wy), q2 = __builtin_bit_cast(f16x2_t, wz), q3 = __builtin_bit_cast(f16x2_t, ww);
                    const float ra = st[m].y, nm = st[m].x;
                    const f32x4 t0 = (f32x4){__builtin_fmaf((float)q0[0], ra, nm), __builtin_fmaf((float)q0[1], ra, nm), __builtin_fmaf((float)q1[0], ra, nm), __builtin_fmaf((float)q1[1], ra, nm)};
                    const f32x4 t1 = (f32x4){__builtin_fmaf((float)q2[0], ra, nm), __builtin_fmaf((float)q2[1], ra, nm), __builtin_fmaf((float)q3[0], ra, nm), __builtin_fmaf((float)q3[1], ra, nm)};
                    const f32x4 z0 = g0 * t0 + (acc[ai][bj][m][0] * sc + b0), z1 = g1 * t1 + (acc[ai][bj][m][1] * sc + b1);
                    { u32x4 w; w.x = cvt_pk_f16(z0[0], z0[1]); w.y = cvt_pk_f16(z0[2], z0[3]); w.z = cvt_pk_f16(z1[0], z1[1]); w.w = cvt_pk_f16(z1[2], z1[3]); *(u32x4*)(zbase + off) = w; }
                    rsum[m] += ((z0[0] + z0[1]) + (z0[2] + z0[3])) + ((z1[0] + z1[1]) + (z1[2] + z1[3]));
                    rsq[m] += ((z0[0] * z0[0] + z0[1] * z0[1]) + (z0[2] * z0[2] + z0[3] * z0[3])) + ((z1[0] * z1[0] + z1[1] * z1[1]) + (z1[2] * z1[2] + z1[3] * z1[3])); }
                asm volatile("" ::: "memory");
                if (ai * 2 + bj < 3) {
#pragma unroll
                    for (int m = 0; m < 4; ++m) xw[m] = xn[m]; } }
#pragma unroll
            for (int m = 0; m < 4; ++m) { float a = rsum[m], q = rsq[m]; a += __shfl_xor(a, 16); q += __shfl_xor(q, 16); a += __shfl_xor(a, 32); q += __shfl_xor(q, 32);
                if (fq == 0) *(f32x2*)(ps + ((size_t)(row0 + ai * HALF + m * 16) * 32 + u.pn * 4 + wc) * 2) = (f32x2){a, q}; }
        }
    }
};
struct EpiConvIn {
    static constexpr bool PERM = true, AFTER_DRAIN = false;
    bf16_t* BG; bf16_t* U; LnFix fix;
    __device__ __forceinline__ void operator()(const f32x4 (&acc)[2][2][4][2], const Unit& u, int wr, int wc, int fr, int fq) const {
        LNFIX_TOP();
        const int row0 = u.pm * BM + wr * 64 + fr;
        if (u.pn < 8) {
            const int col0 = u.pn * BM + wc * 32 + 8 * fq;
#pragma unroll
            for (int ai = 0; ai < 2; ++ai)
#pragma unroll
                for (int m = 0; m < 4; ++m) { bf16_t* rowp = BG + (size_t)(row0 + ai * HALF + m * 16) * 2048 + col0;
#pragma unroll
                    for (int bj = 0; bj < 2; ++bj) *(u32x4*)(rowp + bj * HALF) = pack8(acc[ai][bj][m][0], acc[ai][bj][m][1]); }
        } else {
            const int col0 = (u.pn - 8) * HALF + wc * 32 + 8 * fq;
#pragma unroll
            for (int ai = 0; ai < 2; ++ai)
#pragma unroll
                for (int m = 0; m < 4; ++m) { bf16_t* rowp = U + (size_t)(row0 + ai * HALF + m * 16) * 2048 + col0;
                    *(u32x4*)rowp = pack8(acc[ai][0][m][0] * acc[ai][1][m][0], acc[ai][0][m][1] * acc[ai][1][m][1]); }
        }
    }
};
struct EpiGlaIn {
    static constexpr bool PERM = true, AFTER_DRAIN = false;
    unsigned char* mix; LnFix fix;
    __device__ __forceinline__ void operator()(const f32x4 (&acc)[2][2][4][2], const Unit& u, int wr, int wc, int fr, int fq) const {
        LNFIX_TOP();
        const int row0 = u.pm * BM + wr * 64 + fr;
        bf16_t* const VT = (bf16_t*)(mix + MX_GLA_VT); bf16_t* const R = (bf16_t*)(mix + MX_GLA_R); float* const A = (float*)(mix + MX_GLA_A);
        if (u.pn < 8) {
            bf16_t* base = (bf16_t*)(mix + (u.pn < 4 ? MX_GLA_Q : MX_GLA_K)); const float sc = u.pn < 4 ? 0.0625f : 1.0f; const int col0 = (u.pn & 3) * BM + wc * 32 + 8 * fq;
#pragma unroll
            for (int ai = 0; ai < 2; ++ai)
#pragma unroll
                for (int m = 0; m < 4; ++m) { bf16_t* rowp = base + (size_t)(row0 + ai * HALF + m * 16) * 1024 + col0;
#pragma unroll
                    for (int bj = 0; bj < 2; ++bj) *(u32x4*)(rowp + bj * HALF) = pack8(acc[ai][bj][m][0] * sc, acc[ai][bj][m][1] * sc); }
        } else if (u.pn < 16) {
            const int col0 = (u.pn - 8) * BM + wc * 32 + 8 * fq;
#pragma unroll
            for (int ai = 0; ai < 2; ++ai)
#pragma unroll
                for (int m = 0; m < 4; ++m) { const int row = row0 + ai * HALF + m * 16, b = row >> 11, t = row & 2047;
                    bf16_t* p = VT + ((size_t)b * 2048 + col0) * 2048 + t;
#pragma unroll
                    for (int bj = 0; bj < 2; ++bj)
#pragma unroll
                        for (int n = 0; n < 2; ++n)
#pragma unroll
                            for (int e = 0; e < 4; ++e) p[(size_t)(bj * HALF + 4 * n + e) * 2048] = bf16_1(acc[ai][bj][m][n][e]); }
        } else if (u.pn < 24) {
            const int col0 = (u.pn - 16) * BM + wc * 32 + 8 * fq;
#pragma unroll
            for (int ai = 0; ai < 2; ++ai)
#pragma unroll
                for (int m = 0; m < 4; ++m) { bf16_t* rowp = R + (size_t)(row0 + ai * HALF + m * 16) * 2048 + col0;
#pragma unroll
                    for (int bj = 0; bj < 2; ++bj) { f32x4 s0, s1;
#pragma unroll
                        for (int e = 0; e < 4; ++e) { s0[e] = silu_f(acc[ai][bj][m][0][e]); s1[e] = silu_f(acc[ai][bj][m][1][e]); }
                        *(u32x4*)(rowp + bj * HALF) = pack8(s0, s1); } }
        } else {
            if (wc == 0 && fq < 2) {
#pragma unroll
                for (int ai = 0; ai < 2; ++ai)
#pragma unroll
                    for (int m = 0; m < 4; ++m) { float* rowp = A + (size_t)(row0 + ai * HALF + m * 16) * 16 + 8 * fq;
                        *(f32x4*)rowp = acc[ai][0][m][0]; *(f32x4*)(rowp + 4) = acc[ai][0][m][1]; }
            }
        }
    }
};
struct EpiNsaIn {
    static constexpr bool PERM = true, AFTER_DRAIN = false;
    unsigned char* mix; const float* cosT; const float* sinT; const float* gate_b; float qscale; LnFix fix;
    __device__ __forceinline__ void operator()(const f32x4 (&acc)[2][2][4][2], const Unit& u, int wr, int wc, int fr, int fq) const {
        LNFIX_TOP();
        const int row0 = u.pm * BM + wr * 64 + fr; const int pn = u.pn;
        const bool rope = pn < 10 || pn == 12 || pn == 13 || pn == 16 || pn == 17;
        if (rope) {
            bf16_t* base; int ld, tc0; float sc = 1.0f;
            if (pn < 8) { base = (bf16_t*)(mix + MX_NSA_Q); ld = 2048; tc0 = pn * 256; sc = qscale; }
            else { base = (bf16_t*)(mix + (pn < 10 ? MX_NSA_KC : (pn < 14 ? MX_NSA_KS : MX_NSA_KW))); ld = 512; tc0 = (pn & 1) * 256; }
            const int dd0 = 32 * (wc & 1) + 8 * fq, oc0 = tc0 + (wc >> 1) * 128 + dd0;
#pragma unroll
            for (int ai = 0; ai < 2; ++ai)
#pragma unroll
                for (int m = 0; m < 4; ++m) { const int row = row0 + ai * HALF + m * 16;
                    const f32x4 c0 = *(const f32x4*)(cosT + (size_t)row * 64 + dd0), c1 = *(const f32x4*)(cosT + (size_t)row * 64 + dd0 + 4);
                    const f32x4 s0 = *(const f32x4*)(sinT + (size_t)row * 64 + dd0), s1 = *(const f32x4*)(sinT + (size_t)row * 64 + dd0 + 4);
                    const f32x4 a0 = acc[ai][0][m][0], a1 = acc[ai][0][m][1], b0 = acc[ai][1][m][0], b1 = acc[ai][1][m][1];
                    bf16_t* rowp = base + (size_t)row * ld + oc0;
                    *(u32x4*)rowp = pack8((a0 * c0 - b0 * s0) * sc, (a1 * c1 - b1 * s1) * sc);
                    *(u32x4*)(rowp + 64) = pack8((b0 * c0 + a0 * s0) * sc, (b1 * c1 + a1 * s1) * sc); }
        } else if (pn == 10 || pn == 11) {
            const int col0 = (pn & 1) * BM + wc * 32 + 8 * fq;
#pragma unroll
            for (int ai = 0; ai < 2; ++ai)
#pragma unroll
                for (int m = 0; m < 4; ++m) { bf16_t* rowp = (bf16_t*)(mix + MX_NSA_VC) + (size_t)(row0 + ai * HALF + m * 16) * 512 + col0;
#pragma unroll
                    for (int bj = 0; bj < 2; ++bj) *(u32x4*)(rowp + bj * HALF) = pack8(acc[ai][bj][m][0], acc[ai][bj][m][1]); }
        } else if (pn < 20) {
            bf16_t* VT = (bf16_t*)(mix + (pn < 16 ? MX_NSA_VST : MX_NSA_VWT)); const int col0 = (pn & 1) * BM + wc * 32 + 8 * fq;
#pragma unroll
            for (int ai = 0; ai < 2; ++ai)
#pragma unroll
                for (int m = 0; m < 4; ++m) { const int row = row0 + ai * HALF + m * 16, b = row >> 11, t = row & 2047;
                    bf16_t* p = VT + ((size_t)b * 512 + col0) * 2048 + t;
#pragma unroll
                    for (int bj = 0; bj < 2; ++bj)
#pragma unroll
                        for (int n = 0; n < 2; ++n)
#pragma unroll
                            for (int e = 0; e < 4; ++e) p[(size_t)(bj * HALF + 4 * n + e) * 2048] = bf16_1(acc[ai][bj][m][n][e]); }
        } else {
            const int c0 = 32 * wc + 8 * fq;
            if (c0 < 48) {
                const f32x4 g0 = *(const f32x4*)(gate_b + c0), g1 = *(const f32x4*)(gate_b + c0 + 4);
#pragma unroll
                for (int ai = 0; ai < 2; ++ai)
#pragma unroll
                    for (int m = 0; m < 4; ++m) { float* rowp = (float*)(mix + MX_NSA_GT) + (size_t)(row0 + ai * HALF + m * 16) * 48 + c0; f32x4 o0, o1;
#pragma unroll
                        for (int e = 0; e < 4; ++e) { o0[e] = sigmoid_f(acc[ai][0][m][0][e] + g0[e]); o1[e] = sigmoid_f(acc[ai][0][m][1][e] + g1[e]); }
                        *(f32x4*)rowp = o0; *(f32x4*)(rowp + 4) = o1; }
            }
        }
    }
};
template <class Epi, class Sched, bool ALIGN_EPI = false, bool SP2 = false, bool F16 = false>
__device__ __forceinline__ void gemm_phase(PG8_LAS unsigned char* lds, const Gemm g, const Sched& S, const Epi& E) {
    int tid_o = tidx(lds); asm volatile("" : "+v"(tid_o)); const int tid = tid_o, wid = __builtin_amdgcn_readfirstlane(tid >> 6), lane = tid & 63, wr = wid >> 2, wc = wid & 3, fr = lane & 15, fq = lane >> 4;
    const int K = g.K, nt = K / BK;
    unsigned voffA, voffB;
    { int R, C; stage_rc(tid * 16, R, C); const int Rb = Epi::PERM ? ((R & ~31) + perm32(R & 31)) : R; voffA = (unsigned)(R * K + C) * 2u; voffB = (unsigned)(Rb * K + C) * 2u; }
    const size_t qstep = (size_t)64 * K * 2;
    const size_t kstep = (size_t)(BK * 2);
    const size_t hstep = (size_t)HALF * K * 2;
    const size_t tstep = 2 * hstep;
    const unsigned ldsw = (unsigned)wid * 1024u;
    const int aoff = lds_byte(wr * 64 + fr, fq * 8), boff = lds_byte(wc * 32 + fr, fq * 8);
#define PG8_SA(b, h) (((b) * 2 + (h)) * HTB)
#define PG8_SB(b, h) ((4 + (b) * 2 + (h)) * HTB)
#define PG8_STAGE(bufoff, gbase, voff) do { _Pragma("unroll") for (int _i = 0; _i < 2; ++_i) \
        __builtin_amdgcn_global_load_lds((const unsigned*)((const char*)(gbase) + _i * qstep + (voff)), (PG8_LAS unsigned*)(lds + (bufoff) + ldsw + _i * 8192), 16, 0, 0); } while (0)
#define PG8_LDA(dst, b, h) do { _Pragma("unroll") for (int m = 0; m < 4; ++m) _Pragma("unroll") for (int k = 0; k < 2; ++k) dst[m][k] = *(const PG8_LAS bf16x8*)(lds + PG8_SA(b, h) + aoff + m * 2048 + k * 1024); } while (0)
#define PG8_LDB(dst, b, h) do { _Pragma("unroll") for (int n = 0; n < 2; ++n) _Pragma("unroll") for (int k = 0; k < 2; ++k) dst[n][k] = *(const PG8_LAS bf16x8*)(lds + PG8_SB(b, h) + boff + n * 2048 + k * 1024); } while (0)
#define PG8_MMA(ai, bj, At, Bt) do { __builtin_amdgcn_s_setprio(1); _Pragma("unroll") for (int m = 0; m < 4; ++m) _Pragma("unroll") for (int n = 0; n < 2; ++n) _Pragma("unroll") for (int k = 0; k < 2; ++k) \
        acc[ai][bj][m][n] = mma_sel<F16>(Bt[n][k], At[m][k], acc[ai][bj][m][n]); __builtin_amdgcn_s_setprio(0); } while (0)
#define PG8_WAIT_V(n) asm volatile("s_waitcnt vmcnt(" #n ")" ::: "memory")
#define PG8_WAIT_L(n) asm volatile("s_waitcnt lgkmcnt(" #n ")" ::: "memory")
#define PG8_BAR __builtin_amdgcn_s_barrier()
#define PG8_SCHED __builtin_amdgcn_sched_barrier(0)
    Unit cur, nxt; int ui = 0;
    if (!S.next(0, cur)) return;
    f32x4 acc[2][2][4][2];
#pragma unroll
    for (int a = 0; a < 2; ++a)
#pragma unroll
        for (int b = 0; b < 2; ++b)
#pragma unroll
            for (int m = 0; m < 4; ++m)
#pragma unroll
                for (int n = 0; n < 2; ++n) acc[a][b][m][n] = (f32x4){0.f, 0.f, 0.f, 0.f};
    bf16x8 At[4][2], B0[2][2], B1[2][2];
    const char* cA = (const char*)g.A + (size_t)cur.pm * tstep; const char* cB = (const char*)g.Bt + (size_t)cur.pn * tstep;
    S.a_ready(cur);
    if constexpr (SP2) {
        PG8_STAGE(PG8_SB(0, 0), cB, voffB); PG8_STAGE(PG8_SB(0, 1), cB + hstep, voffB); PG8_STAGE(PG8_SA(0, 0), cA, voffA); PG8_STAGE(PG8_SA(0, 1), cA + hstep, voffA);
        if (wr == 1) PG8_BAR;
        PG8_WAIT_V(2); PG8_BAR;
        PG8_STAGE(PG8_SB(1, 0), cB + kstep, voffB); PG8_STAGE(PG8_SA(1, 0), cA + kstep, voffA); PG8_STAGE(PG8_SB(1, 1), cB + hstep + kstep, voffB);
        PG8_WAIT_V(6); PG8_BAR;
    } else {
        PG8_STAGE(PG8_SB(0, 0), cB, voffB); PG8_STAGE(PG8_SA(0, 0), cA, voffA); PG8_STAGE(PG8_SB(0, 1), cB + hstep, voffB); PG8_STAGE(PG8_SA(0, 1), cA + hstep, voffA);
        if (wr == 1) PG8_BAR;
        PG8_WAIT_V(4); PG8_BAR;
        PG8_STAGE(PG8_SB(1, 0), cB + kstep, voffB); PG8_STAGE(PG8_SA(1, 0), cA + kstep, voffA); PG8_STAGE(PG8_SB(1, 1), cB + hstep + kstep, voffB);
        PG8_WAIT_V(6); PG8_BAR;
    }
    for (;;) {
        const bool has_next = S.next(ui + 1, nxt);
        const char* nA = has_next ? (const char*)g.A + (size_t)nxt.pm * tstep : cA; const char* nB = has_next ? (const char*)g.Bt + (size_t)nxt.pn * tstep : cB;
        for (int t = 0; t < nt; t += 2) {
            const bool last = (t == nt - 2);
            const char* a1 = cA + (size_t)(t + 1) * kstep;
            const char* a2 = last ? nA : cA + (size_t)(t + 2) * kstep; const char* b2 = last ? nB : cB + (size_t)(t + 2) * kstep;
            const char* a3 = a2 + kstep; const char* b3 = b2 + kstep;
            if (last && has_next) S.a_ready(nxt);
            if (t == nt - 4) { if constexpr (F16) stage_lnfix(E.fix, cur, tid, wid); else stage_lnfix(LnFix{E.g, E.b, E.rs, E.aux}, cur, tid, wid); }
            if constexpr (SP2) {
            PG8_LDB(B0, 0, 0); PG8_LDB(B1, 0, 1); PG8_SCHED; PG8_LDA(At, 0, 0); PG8_STAGE(PG8_SA(1, 1), a1 + hstep, voffA);
            PG8_WAIT_V(8); PG8_WAIT_L(0); PG8_BAR; PG8_MMA(0, 0, At, B0); PG8_MMA(0, 1, At, B1); PG8_BAR; PG8_SCHED;
            PG8_LDA(At, 0, 1); PG8_STAGE(PG8_SB(0, 0), b2, voffB); PG8_STAGE(PG8_SB(0, 1), b2 + hstep, voffB); PG8_STAGE(PG8_SA(0, 0), a2, voffA);
            PG8_WAIT_V(8); PG8_WAIT_L(0); PG8_BAR; PG8_MMA(1, 0, At, B0); PG8_MMA(1, 1, At, B1); PG8_BAR; PG8_SCHED;
            PG8_LDB(B0, 1, 0); PG8_LDB(B1, 1, 1); PG8_SCHED; PG8_LDA(At, 1, 0); PG8_STAGE(PG8_SA(0, 1), a2 + hstep, voffA);
            PG8_WAIT_V(8); PG8_WAIT_L(0); PG8_BAR; PG8_MMA(0, 0, At, B0); PG8_MMA(0, 1, At, B1); PG8_BAR; PG8_SCHED;
            PG8_LDA(At, 1, 1); PG8_STAGE(PG8_SB(1, 0), b3, voffB); PG8_STAGE(PG8_SB(1, 1), b3 + hstep, voffB); PG8_STAGE(PG8_SA(1, 0), a3, voffA);
            PG8_WAIT_V(8); PG8_WAIT_L(0); PG8_BAR; PG8_MMA(1, 0, At, B0); PG8_MMA(1, 1, At, B1); PG8_BAR; PG8_SCHED;
            } else {
            PG8_LDB(B0, 0, 0); PG8_SCHED; PG8_LDA(At, 0, 0); PG8_STAGE(PG8_SA(1, 1), a1 + hstep, voffA);
            PG8_WAIT_L(8); PG8_BAR; PG8_WAIT_L(0); PG8_MMA(0, 0, At, B0); PG8_BAR; PG8_SCHED;
            PG8_LDB(B1, 0, 1); PG8_STAGE(PG8_SB(0, 0), b2, voffB);
            PG8_BAR; PG8_WAIT_L(0); PG8_MMA(0, 1, At, B1); PG8_BAR;
            PG8_LDA(At, 0, 1); PG8_STAGE(PG8_SA(0, 0), a2, voffA);
            PG8_BAR; PG8_WAIT_L(0); PG8_MMA(1, 0, At, B0); PG8_BAR; PG8_SCHED;
            PG8_STAGE(PG8_SB(0, 1), b2 + hstep, voffB);
            PG8_WAIT_V(6); PG8_BAR; PG8_MMA(1, 1, At, B1); PG8_BAR;
            PG8_LDB(B0, 1, 0); PG8_SCHED; PG8_LDA(At, 1, 0); PG8_STAGE(PG8_SA(0, 1), a2 + hstep, voffA);
            PG8_WAIT_L(8); PG8_BAR; PG8_WAIT_L(0); PG8_MMA(0, 0, At, B0); PG8_BAR; PG8_SCHED;
            PG8_LDB(B1, 1, 1); PG8_STAGE(PG8_SB(1, 0), b3, voffB);
            PG8_BAR; PG8_WAIT_L(0); PG8_MMA(0, 1, At, B1); PG8_BAR;
            PG8_LDA(At, 1, 1); PG8_STAGE(PG8_SA(1, 0), a3, voffA);
            PG8_BAR; PG8_WAIT_L(0); PG8_MMA(1, 0, At, B0); PG8_BAR; PG8_SCHED;
            PG8_STAGE(PG8_SB(1, 1), b3 + hstep, voffB);
            PG8_WAIT_V(6); PG8_BAR; PG8_MMA(1, 1, At, B1); PG8_BAR;
            }
        }
        if constexpr (ALIGN_EPI) { if (wr == 0) PG8_BAR; }
        if constexpr (!Epi::AFTER_DRAIN) { E(acc, cur, wr, wc, fr, fq); S.done(cur); }
        if (!has_next) break;
#pragma unroll
        for (int a = 0; a < 2; ++a)
#pragma unroll
            for (int b = 0; b < 2; ++b)
#pragma unroll
                for (int m = 0; m < 4; ++m)
#pragma unroll
                    for (int n = 0; n < 2; ++n) acc[a][b][m][n] = (f32x4){0.f, 0.f, 0.f, 0.f};
        cur = nxt; cA = nA; cB = nB; ++ui;
        if constexpr (ALIGN_EPI) { if (wr == 1) PG8_BAR; }
    }
    PG8_WAIT_V(0);
    if constexpr (!ALIGN_EPI) { if (wr == 0) PG8_BAR; }
    PG8_BAR;
    if constexpr (Epi::AFTER_DRAIN) { E.fused(acc, cur, wr, wc, fr, fq, lds, wid, lane); S.done(cur); }
#undef PG8_SA
#undef PG8_SB
#undef PG8_STAGE
#undef PG8_LDA
#undef PG8_LDB
#undef PG8_MMA
#undef PG8_WAIT_V
#undef PG8_WAIT_L
#undef PG8_BAR
#undef PG8_SCHED
}
}
#ifndef PG8_SP2
#define PG8_SP2 true
#endif
#ifndef PG8_ALIGN
#define PG8_ALIGN true
#endif
constexpr int NB = 16, T = 2048, D = 2048, M = NB * T, DFF = 5632, DEPTH = 4, NWAVES = 8;
constexpr float LN_EPS = 1e-5f, ALPHA = 1.6817928305074292f;
constexpr int NSA_NPAD = 5376, NSA_NSRC = 5168, CONV_N = 6144, GLA_NPAD = 6400, GLA_NSRC = 6160;
enum { I_X = 0, I_POS, I_LNG, I_LNB, I_FFN_WIN, I_FFN_WOUT, I_NSA_WIN, I_NSA_GB, I_NSA_CPOS, I_NSA_CW1, I_NSA_CW2, I_NSA_WOUT,
       I_CONV_WIN, I_CONV_W, I_CONV_WOUT, I_GLA_WIN, I_GLA_WA2, I_GLA_BA, I_GLA_NG, I_GLA_WOUT, N_IN };
constexpr size_t WS_CTL = 0, CTL_ZERO_BYTES = 1 * MiB;
constexpr size_t WS_COS = 1 * MiB, WS_SIN = 9 * MiB;
constexpr size_t WS_MISC = 17 * MiB;
constexpr size_t WS_RS = WS_MISC + 256 * 1024;
constexpr size_t SZ_FFN_WIN = (size_t)2 * DFF * D * 2, SZ_FFN_WOUT = (size_t)D * DFF * 2;
constexpr size_t WS_FFN_WIN = 18 * MiB, WS_FFN_WOUT = WS_FFN_WIN + 8 * SZ_FFN_WIN;
constexpr size_t SZ_NSA_WIN = (size_t)NSA_NPAD * D * 2, SZ_DD = (size_t)D * D * 2;
constexpr size_t WS_NSA_WIN = WS_FFN_WOUT + 8 * SZ_FFN_WOUT, WS_NSA_WOUT = WS_NSA_WIN + 2 * SZ_NSA_WIN;
constexpr size_t WS_CONV_WIN = WS_NSA_WOUT + 2 * SZ_DD, WS_CONV_WOUT = WS_CONV_WIN + (size_t)CONV_N * D * 2;
constexpr size_t WS_GLA_WIN = WS_CONV_WOUT + SZ_DD, WS_GLA_WOUT = WS_GLA_WIN + (size_t)GLA_NPAD * D * 2;
constexpr size_t WS_CMP_W1T = WS_GLA_WOUT + SZ_DD, WS_CMP_W2T = WS_CMP_W1T + 4 * (size_t)128 * 4096 * 2;
constexpr size_t WS_XB = WS_CMP_W2T + 1 * MiB;
constexpr size_t WS_MIX = WS_XB + (size_t)M * D * 2;
constexpr size_t WS_A2 = WS_MIX + 640 * MiB;
constexpr size_t WS_PS = WS_A2 + (size_t)M * D * 2;
constexpr size_t WS_PART = WS_PS + 16 * MiB;
constexpr size_t WS_CSBV = WS_PART + 12 * 4 * MiB;
constexpr size_t WS_ZDUMMY = WS_CSBV + 2 * MiB;
constexpr size_t WS_END = WS_ZDUMMY + (size_t)M * D * 2;
static_assert(WS_FFN_WIN % 256 == 0 && WS_NSA_WIN % 256 == 0 && WS_XB % 256 == 0 && WS_MIX % 256 == 0, "ws alignment");
static_assert((size_t)M * DFF * 2 <= 640 * MiB, "H fits the mixer region");
constexpr int CW_BAR = 4096;
constexpr int RING_OFF = 0, RING_BYTES = 131072;
constexpr int LDSCTL_OFF = 144896, MISC_OFF = LDSCTL_OFF + 320;
constexpr int LDS_BYTES = 147456;
static_assert(MISC_OFF + 128 <= LDS_BYTES, "LDS map");
static_assert(pg8::WIDTAB_BYTE == LDSCTL_OFF + 1024 && pg8::WIDTAB_BYTE + 256 <= LDS_BYTES && RING_OFF == 0, "wave-index table");

#define GAS __attribute__((address_space(1)))
#define LAS __attribute__((address_space(3)))
typedef unsigned short bf16;
typedef unsigned v4u __attribute__((ext_vector_type(4)));
typedef unsigned v2u __attribute__((ext_vector_type(2)));
typedef float f32x4 __attribute__((ext_vector_type(4)));
typedef short bf16x8 __attribute__((ext_vector_type(8)));
#define LDS_WAIT() asm volatile("s_waitcnt lgkmcnt(0)" ::: "memory")
#define VM_WAIT() asm volatile("s_waitcnt vmcnt(0)" ::: "memory")
__device__ __forceinline__ unsigned pk2(float lo, float hi) { return pg8::cvt_pk_bf16(lo, hi); }
__device__ __forceinline__ float bf_lo(unsigned w) { return __builtin_bit_cast(float, w << 16); }
__device__ __forceinline__ float bf_hi(unsigned w) { return __builtin_bit_cast(float, w & 0xffff0000u); }
#define XB_TMO      128
#define XB_XCNT(j)  (256  + 64 * (j))
#define XB_XSUB(j)  (1280 + 64 * (j))
#define XB_XGEN(j)  (2304 + 64 * (j))
#define XB_TOP      3328
#define XB_TOPGEN   3392
#define XCD_BAR_WORDS 3456
#define XB_SPIN_CAP (1u << 18)

__device__ __forceinline__ unsigned xb_ld(unsigned* p)              { return __hip_atomic_load(p, __ATOMIC_RELAXED, __HIP_MEMORY_SCOPE_AGENT); }
__device__ __forceinline__ unsigned xb_add(unsigned* p, unsigned v) { return __hip_atomic_fetch_add(p, v, __ATOMIC_RELAXED, __HIP_MEMORY_SCOPE_AGENT); }
__device__ __forceinline__ unsigned xb_xcc_id() { return (unsigned)__builtin_amdgcn_s_getreg((3 << 11) | 20) & 0xFu; }
#define XB_SPIN(cond, bar) do { unsigned _sp = 0; while (cond) { __builtin_amdgcn_s_sleep(1); \
    if ((++_sp & 255u) == 0u) { if (xb_ld(&(bar)[XB_TMO])) break; if (_sp > XB_SPIN_CAP) { atomicAdd(&(bar)[XB_TMO], 1u); break; } } } } while (0)

struct XcdBarrier {
    unsigned* bar; unsigned x;
    volatile LAS unsigned* st;
};

__device__ __forceinline__ XcdBarrier xcd_barrier_post(unsigned* bar, volatile LAS unsigned* st) {
    XcdBarrier b; b.bar = bar; b.x = xb_xcc_id(); b.st = st;
    if (pg8::tidx((const LAS unsigned char*)st - (MISC_OFF + 32)) == 0) (void)xb_add(&bar[XB_XCNT(b.x)], 1u);
    return b;
}
__device__ __forceinline__ void xcd_barrier_complete(unsigned* bar, unsigned x, unsigned& nloc, unsigned& nx) {
    const unsigned G = gridDim.x * gridDim.y * gridDim.z;
    unsigned sum, cnt, mine, sp = 0u;
    for (;;) {
        sum = 0u; cnt = 0u; mine = 0u;
#pragma unroll
        for (unsigned j = 0; j < 16; ++j) { const unsigned c = xb_ld(&bar[XB_XCNT(j)]); sum += c; cnt += (c > 0u) ? 1u : 0u; mine = (j == x) ? c : mine; }
        if (sum == G) break;
        __builtin_amdgcn_s_sleep(1);
        if ((++sp & 255u) == 0u) { if (xb_ld(&bar[XB_TMO])) break; if (sp > XB_SPIN_CAP) { atomicAdd(&bar[XB_TMO], 1u); break; } }
    }
    nloc = mine > 0u ? mine : 1u; nx = cnt > 0u ? cnt : 1u;
}

__device__ __forceinline__ void xcd_barrier(const XcdBarrier& b) {
    asm volatile("s_waitcnt vmcnt(0)" ::: "memory");
    __syncthreads();
    if (pg8::tidx((const LAS unsigned char*)b.st - (MISC_OFF + 32)) == 0) {
        unsigned* bar = b.bar; asm volatile("" : "+s"(bar));
        __builtin_amdgcn_s_waitcnt(0);
        unsigned nloc = b.st[0], nx = b.st[1];
        if (nloc == 0u) { xcd_barrier_complete(bar, b.x, nloc, nx); b.st[0] = nloc; b.st[1] = nx; }
        unsigned bx_ = b.x; asm volatile("" : "+s"(bx_));
        const unsigned old = xb_add(&bar[XB_XSUB(bx_)], 1u);
        const unsigned gen = old / nloc;
        if (old + 1u == (gen + 1u) * nloc) {
            __builtin_amdgcn_fence(__ATOMIC_RELEASE, "agent");
            asm volatile("s_waitcnt vmcnt(0)" ::: "memory");
            const unsigned og = xb_add(&bar[XB_TOP], 1u);
            const unsigned tg = og / nx;
            if (og + 1u == (tg + 1u) * nx) xb_add(&bar[XB_TOPGEN], 1u);
            else XB_SPIN(xb_ld(&bar[XB_TOPGEN]) == tg, bar);
            __builtin_amdgcn_fence(__ATOMIC_ACQUIRE, "agent");
            xb_add(&bar[XB_XGEN(bx_)], 1u);
            asm volatile("s_waitcnt vmcnt(0)" ::: "memory");
        } else {
            XB_SPIN(xb_ld(&bar[XB_XGEN(bx_)]) == gen, bar);
            __builtin_amdgcn_fence(__ATOMIC_ACQUIRE, "agent");
            asm volatile("s_waitcnt vmcnt(0)" ::: "memory");
        }
    }
    __syncthreads();
}
template <int KSTEPS>
__device__ __forceinline__ f32x4 mma16(f32x4 acc, const LAS unsigned char* Aimg, int strideA, int m0, const LAS unsigned char* Bimg, int strideB, int n0, int lane) {
    const LAS unsigned char* ap = Aimg + (m0 + (lane & 15)) * strideA + (lane >> 4) * 16;
    const LAS unsigned char* bp = Bimg + (n0 + (lane & 15)) * strideB + (lane >> 4) * 16;
#pragma unroll
    for (int ks = 0; ks < KSTEPS; ++ks) {
        const bf16x8 a = *(const LAS bf16x8*)(ap + ks * 64), b = *(const LAS bf16x8*)(bp + ks * 64);
        acc = __builtin_amdgcn_mfma_f32_16x16x32_bf16(a, b, acc, 0, 0, 0);
    }
    return acc;
}

__device__ __forceinline__ float logsigmoid_f(float z) { return fminf(z, 0.f) - __logf(1.f + __expf(-fabsf(z))); }
__device__ __forceinline__ void gla_prep(unsigned char* ws, const float* w_a2, const float* b_a, LAS unsigned char* lds, int vcu, int G) {
    int tid = pg8::tidx(lds); asm volatile("" : "+v"(tid));
    bf16* Q = (bf16*)(ws + WS_MIX + MX_GLA_Q); bf16* K = (bf16*)(ws + WS_MIX + MX_GLA_K);
    const float* A = (const float*)(ws + WS_MIX + MX_GLA_A); float* DEC = (float*)(ws + WS_MIX + MX_GLA_DEC);
    LAS float* la = (LAS float*)lds;
    LAS float* lt = (LAS float*)(lds + 4096);
    const int d = tid & 255, half = tid >> 8;
    for (int item = vcu; item < NB * 32 * 4; item += G) {
        const int h = item & 3, n = (item >> 2) & 31, b = item >> 7; const int col = h * 256 + d; const size_t row0 = (size_t)b * T + n * 64;
        __syncthreads();
        for (int i = tid; i < 64 * 16; i += 512) la[i] = A[row0 * 16 + i];
        float w[16];
#pragma unroll
        for (int j = 0; j < 16; ++j) w[j] = w_a2[(size_t)j * 1024 + col];
        const float ba = b_a[col];
        __syncthreads();
        float bc[32]; float run = 0.f;
#pragma unroll
        for (int r = 0; r < 32; ++r) { const LAS f32x4* ar = (const LAS f32x4*)(la + (half * 32 + r) * 16); float z = ba;
#pragma unroll
            for (int j4 = 0; j4 < 4; ++j4) { const f32x4 av = ar[j4]; z += (av[0] * w[4 * j4] + av[1] * w[4 * j4 + 1]) + (av[2] * w[4 * j4 + 2] + av[3] * w[4 * j4 + 3]); }
            run += logsigmoid_f(z) * (1.f / 16.f); bc[r] = run; }
        if (half == 0) lt[d] = run;
        __syncthreads();
        const float tot0 = lt[d]; const float off = half ? tot0 : 0.f; const float blast = half ? (tot0 + run) : 0.f;
        if (half == 1) lt[d] = blast;
        __syncthreads();
        const float bl = lt[d];
        if (half == 1) DEC[((size_t)b * 32 + n) * 1024 + col] = __expf(bl);
#pragma unroll
        for (int r = 0; r < 32; ++r) { const size_t gi = (row0 + half * 32 + r) * 1024 + col; const float bb = bc[r] + off;
            const float qv = bf_lo((unsigned)Q[gi]), kv = bf_lo((unsigned)K[gi]);
            const float eb = __expf(bb); Q[gi] = pg8::bf16_1(qv * eb); K[gi] = pg8::bf16_1(kv * __builtin_amdgcn_rcpf(eb)); }
    }
}
constexpr int GL_SQ = 544, GL_S64 = 160;
constexpr int GL_QD = 0, GL_KD = GL_QD + 64 * GL_SQ, GL_VT = GL_KD + 64 * GL_SQ, GL_ST = GL_VT + 64 * GL_S64, GL_AI = GL_ST + 64 * GL_SQ, GL_SS = GL_AI + 64 * GL_S64, GL_END = GL_SS + 64 * 4 * 4;
static_assert(GL_END <= LDSCTL_OFF, "GLA LDS map");
typedef short v4i16_t __attribute__((ext_vector_type(4)));
__device__ __forceinline__ void gla_scan(unsigned char* ws, LAS unsigned char* lds, int vcu, int G) {
    int tid = pg8::tidx(lds); asm volatile("" : "+v"(tid));
    const int lane = tid & 63, w = __builtin_amdgcn_readfirstlane(tid >> 6);
    const bf16* QD = (const bf16*)(ws + WS_MIX + MX_GLA_Q); const bf16* KD = (const bf16*)(ws + WS_MIX + MX_GLA_K); const bf16* VTg = (const bf16*)(ws + WS_MIX + MX_GLA_VT);
    const float* DEC = (const float*)(ws + WS_MIX + MX_GLA_DEC);
    bf16* O = (bf16*)(ws + WS_MIX + MX_GLA_O); float* SSQ = (float*)(ws + WS_MIX + MX_GLA_SSQ);
    for (int unit = vcu; unit < NB * 4 * 8; unit += G) {
        const int vs = unit & 7, h = (unit >> 3) & 3, b = unit >> 5;
        f32x4 st[8];
#pragma unroll
        for (int i = 0; i < 8; ++i) st[i] = (f32x4){0.f, 0.f, 0.f, 0.f};
        v4u q4[4], k4[4], v1;
#define GLA_LOAD_TILES(nn) do { const size_t r0_ = (size_t)b * T + (nn) * 64; _Pragma("unroll") for (int i = 0; i < 4; ++i) { const int c = tid + 512 * i, r = c >> 5, cc = c & 31; \
            q4[i] = *(const v4u*)(QD + (r0_ + r) * 1024 + h * 256 + cc * 8); k4[i] = *(const v4u*)(KD + (r0_ + r) * 1024 + h * 256 + cc * 8); } \
            { const int r = tid >> 3, cc = tid & 7; v1 = *(const v4u*)(VTg + ((size_t)b * 2048 + h * 512 + vs * 64 + r) * 2048 + (nn) * 64 + cc * 8); } } while (0)
#define GLA_STORE_TILES() do { _Pragma("unroll") for (int i = 0; i < 4; ++i) { const int c = tid + 512 * i, r = c >> 5, cc = c & 31; *(LAS v4u*)(lds + GL_QD + r * GL_SQ + cc * 16) = q4[i]; *(LAS v4u*)(lds + GL_KD + r * GL_SQ + cc * 16) = k4[i]; } \
            { const int r = tid >> 3, cc = tid & 7; *(LAS v4u*)(lds + GL_VT + r * GL_S64 + cc * 16) = v1; } } while (0)
        GLA_LOAD_TILES(0);
        __syncthreads();
        { unsigned z = 0u; asm volatile("" : "+v"(z)); for (int i = tid; i < 64 * GL_SQ / 16; i += 512) *(LAS v4u*)(lds + GL_ST + i * 16) = (v4u){z, z, z, z}; }
        GLA_STORE_TILES();
        for (int n = 0; n < 32; ++n) {
            const size_t row0 = (size_t)b * T + n * 64;
            __syncthreads();
            if (n < 31) GLA_LOAD_TILES(n + 1);
            {
                const int tm = w >> 1;
#pragma unroll
                for (int j = 0; j < 2; ++j) { const int tn = 2 * (w & 1) + j; f32x4 a = (f32x4){0.f, 0.f, 0.f, 0.f};
                    if (tn <= tm) a = mma16<8>(a, lds + GL_QD, GL_SQ, tm * 16, lds + GL_KD, GL_SQ, tn * 16, lane);
                    const int sx = tn * 16 + (lane & 15);
#pragma unroll
                    for (int r = 0; r < 4; ++r) { const int c = tm * 16 + 4 * (lane >> 4) + r; const float v = (sx <= c) ? a[r] : 0.f;
                        *(LAS unsigned short*)(lds + GL_AI + c * GL_S64 + sx * 2) = pg8::bf16_1(v); } }
            }
            {
                const int g4 = lane >> 4, q = (lane & 15) >> 2, p = lane & 3;
#pragma unroll
                for (int dt = 0; dt < 2; ++dt) { const int dtile = 2 * w + dt; const float dec = DEC[((size_t)b * 32 + n) * 1024 + h * 256 + dtile * 16 + (lane & 15)];
                    bf16x8 bfr[2];
#pragma unroll
                    for (int ks = 0; ks < 2; ++ks) { const LAS unsigned char* kp = lds + GL_KD + (32 * ks + 8 * g4 + q) * GL_SQ + (16 * dtile + 4 * p) * 2;
                        const v4i16_t lo = __builtin_amdgcn_ds_read_tr16_b64_v4i16((LAS v4i16_t*)kp), hi = __builtin_amdgcn_ds_read_tr16_b64_v4i16((LAS v4i16_t*)(kp + 4 * GL_SQ));
                        bfr[ks] = (bf16x8){lo[0], lo[1], lo[2], lo[3], hi[0], hi[1], hi[2], hi[3]}; }
#pragma unroll
                    for (int vt = 0; vt < 4; ++vt) { f32x4 a = st[dt * 4 + vt];
                        const LAS unsigned char* ap = lds + GL_VT + (vt * 16 + (lane & 15)) * GL_S64 + (lane >> 4) * 16;
#pragma unroll
                        for (int ks = 0; ks < 2; ++ks) a = __builtin_amdgcn_mfma_f32_16x16x32_bf16(*(const LAS bf16x8*)(ap + ks * 64), bfr[ks], a, 0, 0, 0);
                        st[dt * 4 + vt] = a * dec; } }
            }
            __syncthreads();
            {
                const int tm = w >> 1;
#pragma unroll
                for (int j = 0; j < 2; ++j) { const int tn = 2 * (w & 1) + j; f32x4 o = (f32x4){0.f, 0.f, 0.f, 0.f};
                    o = mma16<2>(o, lds + GL_AI, GL_S64, tm * 16, lds + GL_VT, GL_S64, tn * 16, lane);
                    o = mma16<8>(o, lds + GL_QD, GL_SQ, tm * 16, lds + GL_ST, GL_SQ, tn * 16, lane);
                    const int v = tn * 16 + (lane & 15);
#pragma unroll
                    for (int r = 0; r < 4; ++r) { const int c = tm * 16 + 4 * (lane >> 4) + r;
                        O[(row0 + c) * 2048 + h * 512 + vs * 64 + v] = pg8::bf16_1(o[r]);
                        float qq = o[r] * o[r]; qq += __shfl_xor(qq, 1); qq += __shfl_xor(qq, 2); qq += __shfl_xor(qq, 4); qq += __shfl_xor(qq, 8);
                        if ((lane & 15) == 0) *(LAS float*)(lds + GL_SS + (c * 4 + tn) * 4) = qq; } }
            }
            __syncthreads();
            if (tid < 64) { const LAS float* pp = (const LAS float*)(lds + GL_SS + tid * 16); SSQ[(row0 + tid) * 32 + h * 8 + vs] = (pp[0] + pp[1]) + (pp[2] + pp[3]); }
#pragma unroll
            for (int dt = 0; dt < 2; ++dt) { const int dcol = (2 * w + dt) * 16 + (lane & 15);
#pragma unroll
                for (int vt = 0; vt < 4; ++vt)
#pragma unroll
                    for (int r = 0; r < 4; ++r) { const int v = vt * 16 + 4 * (lane >> 4) + r; *(LAS unsigned short*)(lds + GL_ST + v * GL_SQ + dcol * 2) = pg8::bf16_1(st[dt * 4 + vt][r]); } }
            if (n < 31) GLA_STORE_TILES();
        }
    }
}
__device__ __forceinline__ void gla_out(unsigned char* ws, const float* norm_g, bf16* XB, int vcu, int NT, const LAS unsigned char* lds) {
    int gtid = pg8::tidx(lds); asm volatile("" : "+v"(gtid)); gtid += vcu * (NWAVES * 64);
    const bf16* O = (const bf16*)(ws + WS_MIX + MX_GLA_O); const bf16* R = (const bf16*)(ws + WS_MIX + MX_GLA_R); const float* SSQ = (const float*)(ws + WS_MIX + MX_GLA_SSQ);
    for (int idx = gtid; idx < M * 256; idx += NT) {
        const int m = idx >> 8, col = (idx & 255) * 8, h = col >> 9, v = col & 511;
        const f32x4 s0 = *(const f32x4*)(SSQ + (size_t)m * 32 + h * 8), s1 = *(const f32x4*)(SSQ + (size_t)m * 32 + h * 8 + 4);
        const float ss = ((s0.x + s0.y) + (s0.z + s0.w)) + ((s1.x + s1.y) + (s1.z + s1.w));
        const float rs = 1.f / sqrtf(ss * (1.f / 512.f) + LN_EPS);
        const v4u o = *(const v4u*)(O + (size_t)m * D + col), r = *(const v4u*)(R + (size_t)m * D + col);
        const f32x4 g0 = *(const f32x4*)(norm_g + v), g1 = *(const f32x4*)(norm_g + v + 4);
        float y[8];
#pragma unroll
        for (int p = 0; p < 4; ++p) { const float gl = p < 2 ? g0[2 * p] : g1[2 * p - 4], gh = p < 2 ? g0[2 * p + 1] : g1[2 * p - 3];
            y[2 * p] = bf_lo(o[p]) * rs * gl * bf_lo(r[p]); y[2 * p + 1] = bf_hi(o[p]) * rs * gh * bf_hi(r[p]); }
        v4u w; w.x = pk2(y[0], y[1]); w.y = pk2(y[2], y[3]); w.z = pk2(y[4], y[5]); w.w = pk2(y[6], y[7]);
        *(v4u*)(XB + (size_t)m * D + col) = w;
    }
}
constexpr float NSA_QSCALE = 0.08838834764831845f * 1.4426950408889634f;
typedef float f32x16 __attribute__((ext_vector_type(16)));
typedef short s16x4 __attribute__((ext_vector_type(4)));

__device__ __forceinline__ float gelu_tanh_f(float x) { const float u = 0.7978845608028654f * (x + 0.044715f * x * x * x); const float e = __expf(2.f * u); const float th = 1.f - 2.f * __builtin_amdgcn_rcpf(e + 1.f); return 0.5f * x * (1.f + th); }

constexpr int CP_HID = 0, CP_HS = 288, CP_A0 = 32768;
__device__ __forceinline__ void nsa_compress(unsigned char* ws, int mj, LAS unsigned char* lds, int vcu, int G) {
    for (int unit = vcu; unit < NB * 4 * 2 * 2; unit += G) {
        int tid = pg8::tidx(lds); asm volatile("" : "+v"(tid));
        const int lane = tid & 63, w = __builtin_amdgcn_readfirstlane(tid >> 6);
        const int nh = unit & 1, kv = (unit >> 1) & 1, g = (unit >> 2) & 3, b = unit >> 4, f = mj * 2 + kv;
        const bf16* src = (const bf16*)(ws + WS_MIX + (kv ? MX_NSA_VC : MX_NSA_KC)) + (size_t)b * T * 512 + g * 128;
        const bf16* w1t = (const bf16*)(ws + WS_CMP_W1T) + (size_t)f * 128 * 4096;
        const bf16* w2t = (const bf16*)(ws + WS_CMP_W2T) + (size_t)f * 128 * 128;
        const float* bias1 = (const float*)(ws + WS_MISC) + f * 128;
        f32x4 acc[4];
#pragma unroll
        for (int i = 0; i < 4; ++i) acc[i] = (f32x4){0.f, 0.f, 0.f, 0.f};
        const bf16* bp = w1t + (size_t)(16 * w + (lane & 15)) * 4096 + (lane >> 4) * 8;
        v4u ar0[2], ar1[2]; bf16x8 bfa[4], bfb[4];
#define CP_ALOAD(AR, L) do { _Pragma("unroll") for (int i = 0; i < 2; ++i) { const int c = tid + 512 * i; int t = 16 * (nh * 64 + (c >> 4)) + (L); t = t > T - 1 ? T - 1 : t; \
            AR[i] = *(const v4u*)(src + (size_t)t * 512 + (c & 15) * 8); } } while (0)
#define CP_ASTORE(AR, BUF) do { _Pragma("unroll") for (int i = 0; i < 2; ++i) { const int c = tid + 512 * i, row = c >> 4; \
            *(LAS v4u*)(lds + CP_A0 + (BUF) * 16384 + row * 256 + (((c & 15) ^ (row & 15)) << 4)) = AR[i]; } } while (0)
#define CP_BLOAD(BFR, L) do { _Pragma("unroll") for (int q4 = 0; q4 < 4; ++q4) BFR[q4] = *(const bf16x8*)(bp + ((L) * 4 + q4) * 32); } while (0)
#define CP_MMA(BFR, BUF) do { _Pragma("unroll") for (int mt = 0; mt < 4; ++mt) { const int row = mt * 16 + (lane & 15); const LAS unsigned char* rp = lds + CP_A0 + (BUF) * 16384 + row * 256; \
            _Pragma("unroll") for (int q4 = 0; q4 < 4; ++q4) acc[mt] = __builtin_amdgcn_mfma_f32_16x16x32_bf16(*(const LAS bf16x8*)(rp + (((q4 * 4 + (lane >> 4)) ^ (row & 15)) << 4)), BFR[q4], acc[mt], 0, 0, 0); } } while (0)
        CP_ALOAD(ar0, 0); CP_ALOAD(ar1, 1); CP_BLOAD(bfa, 0);
        __syncthreads();
        CP_ASTORE(ar0, 0);
#pragma unroll 1
        for (int l = 0; l < 32; l += 2) {
            __syncthreads();
            if (l + 2 < 32) CP_ALOAD(ar0, l + 2);
            CP_BLOAD(bfb, l + 1);
            CP_MMA(bfa, 0);
            CP_ASTORE(ar1, 1);
            __syncthreads();
            if (l + 2 < 32) { CP_ALOAD(ar1, l + 3); CP_BLOAD(bfa, l + 2); }
            CP_MMA(bfb, 1);
            if (l + 2 < 32) CP_ASTORE(ar0, 0);
        }
#undef CP_ALOAD
#undef CP_ASTORE
#undef CP_BLOAD
#undef CP_MMA
        const float b1 = bias1[16 * w + (lane & 15)];
        __syncthreads();
#pragma unroll
        for (int mt = 0; mt < 4; ++mt)
#pragma unroll
            for (int r = 0; r < 4; ++r) { const int n = mt * 16 + 4 * (lane >> 4) + r; *(LAS unsigned short*)(lds + CP_HID + n * CP_HS + (16 * w + (lane & 15)) * 2) = pg8::bf16_1(gelu_tanh_f(acc[mt][r] + b1)); }
        __syncthreads();
        const bf16* b2p = w2t + (size_t)(16 * w + (lane & 15)) * 128 + (lane >> 4) * 8;
        bf16x8 b2[4];
#pragma unroll
        for (int ks = 0; ks < 4; ++ks) b2[ks] = *(const bf16x8*)(b2p + ks * 32);
#pragma unroll
        for (int mt = 0; mt < 4; ++mt) { f32x4 o = (f32x4){0.f, 0.f, 0.f, 0.f};
            const LAS unsigned char* ap = lds + CP_HID + (mt * 16 + (lane & 15)) * CP_HS + (lane >> 4) * 16;
#pragma unroll
            for (int ks = 0; ks < 4; ++ks) o = __builtin_amdgcn_mfma_f32_16x16x32_bf16(*(const LAS bf16x8*)(ap + ks * 64), b2[ks], o, 0, 0, 0);
            const int d2 = 16 * w + (lane & 15);
#pragma unroll
            for (int r = 0; r < 4; ++r) { const int n = nh * 64 + mt * 16 + 4 * (lane >> 4) + r; const unsigned short v = n < 127 ? pg8::bf16_1(o[r]) : (unsigned short)0;
                if (kv == 0) ((bf16*)(ws + WS_MIX + MX_NSA_KCMP))[((size_t)(b * 4 + g) * 128 + n) * 128 + d2] = v;
                else         ((bf16*)(ws + WS_MIX + MX_NSA_VCMPT))[((size_t)(b * 4 + g) * 128 + d2) * 128 + n] = v; } }
    }
}

constexpr int AT_K0 = 0, AT_KB = 16384, AT_V0 = 32768, AT_VS = 144, AT_VB = 128 * AT_VS, AT_MASK = AT_V0 + 2 * AT_VB, AT_IMP = AT_MASK + 256, AT_OC = AT_IMP, AT_END = AT_OC + 16 * 512 * 8;
static_assert(AT_END <= LDSCTL_OFF, "attention LDS map");
enum { MODE_CMP = 0, MODE_SEL = 1, MODE_WIN = 2 };
__device__ __forceinline__ void at_load(v4u (&kr)[2], v4u (&vr)[2], const bf16* Kb, int pitchK, const bf16* Vb, int pitchV, int j, int tid) {
    const unsigned ko = (unsigned)(((tid >> 4) * pitchK + (tid & 15) * 8) * 2), vo = (unsigned)(((tid >> 3) * pitchV + (tid & 7) * 8) * 2);
    const unsigned char* kbj = (const unsigned char*)(Kb + (size_t)j * 64 * pitchK); const unsigned char* vbj = (const unsigned char*)(Vb + j * 64);
    kr[0] = *(const v4u*)(kbj + ko); kr[1] = *(const v4u*)(kbj + (size_t)64 * pitchK + ko);
    vr[0] = *(const v4u*)(vbj + vo); vr[1] = *(const v4u*)(vbj + (size_t)128 * pitchV + vo);
}
__device__ __forceinline__ void at_store(const v4u (&kr)[2], const v4u (&vr)[2], LAS unsigned char* lds, int buf, int tid) {
#pragma unroll
    for (int i = 0; i < 2; ++i) { const int c = tid + 512 * i; const int row = c >> 4, slot = c & 15;
        *(LAS v4u*)(lds + AT_K0 + buf * AT_KB + row * 256 + ((slot ^ (row & 15)) << 4)) = kr[i];
        LAS unsigned char* vp = lds + AT_V0 + buf * AT_VB + (c >> 3) * AT_VS + ((c & 7) >> 1) * 32 + (c & 1) * 8;
        *(LAS v2u*)vp = (v2u){vr[i].x, vr[i].y}; *(LAS v2u*)(vp + 16) = (v2u){vr[i].z, vr[i].w}; }
}
__device__ __forceinline__ f32x16 at_qk(const LAS unsigned char* kb, int kt, const bf16x8 (&qf)[8], int lane) {
    f32x16 s;
#pragma unroll
    for (int i = 0; i < 16; ++i) s[i] = 0.f;
    const int row = kt * 32 + (lane & 31); const LAS unsigned char* rp = kb + row * 256; const int sw = (row & 15) << 4, hb = (lane >> 5) << 4;
#pragma unroll
    for (int kk = 0; kk < 8; ++kk) { const bf16x8 a = *(const LAS bf16x8*)(rp + ((32 * kk + hb) ^ sw)); s = __builtin_amdgcn_mfma_f32_32x32x16_bf16(a, qf[kk], s, 0, 0, 0); }
    return s;
}
__device__ __forceinline__ void at_pv(f32x16 (&o)[4], const LAS unsigned char* vb, int kt, const f32x16& p, int lane) {
#pragma unroll
    for (int s2 = 0; s2 < 2; ++s2) {
        bf16x8 pf;
        { v4u t; t.x = pk2(p[8 * s2 + 0], p[8 * s2 + 1]); t.y = pk2(p[8 * s2 + 2], p[8 * s2 + 3]); t.z = pk2(p[8 * s2 + 4], p[8 * s2 + 5]); t.w = pk2(p[8 * s2 + 6], p[8 * s2 + 7]); pf = __builtin_bit_cast(bf16x8, t); }
        const int cb = 64 * kt + 32 * s2 + 16 * (lane >> 5);
#pragma unroll
        for (int dt = 0; dt < 4; ++dt) { const bf16x8 a = *(const LAS bf16x8*)(vb + (32 * dt + (lane & 31)) * AT_VS + cb);
            o[dt] = __builtin_amdgcn_mfma_f32_32x32x16_bf16(a, pf, o[dt], 0, 0, 0); }
    }
}
__device__ __forceinline__ void at_kload(bf16x8 (&ka)[16], const LAS unsigned char* kb, int lane) {
#pragma unroll
    for (int kt = 0; kt < 2; ++kt) { const int row = kt * 32 + (lane & 31); const LAS unsigned char* rp = kb + row * 256; const int sw = (row & 15) << 4, hb = (lane >> 5) << 4;
#pragma unroll
        for (int kk = 0; kk < 8; ++kk) ka[kt * 8 + kk] = *(const LAS bf16x8*)(rp + ((32 * kk + hb) ^ sw)); }
}
__device__ __forceinline__ void at_vload(bf16x8 (&va)[8], const LAS unsigned char* vb, int kt, int lane) {
    const LAS unsigned char* vp = vb + (lane & 31) * AT_VS + 16 * (lane >> 5) + 64 * kt;
#pragma unroll
    for (int s2 = 0; s2 < 2; ++s2)
#pragma unroll
        for (int dt = 0; dt < 4; ++dt) va[s2 * 4 + dt] = *(const LAS bf16x8*)(vp + 32 * dt * AT_VS + 32 * s2);
}
template <int S2>
__device__ __forceinline__ void at_pv_r(f32x16 (&o)[4], const bf16x8 (&va)[8], const f32x16& p) {
    bf16x8 pf;
    { v4u t; t.x = pk2(p[8 * S2 + 0], p[8 * S2 + 1]); t.y = pk2(p[8 * S2 + 2], p[8 * S2 + 3]); t.z = pk2(p[8 * S2 + 4], p[8 * S2 + 5]); t.w = pk2(p[8 * S2 + 6], p[8 * S2 + 7]); pf = __builtin_bit_cast(bf16x8, t); }
#pragma unroll
    for (int dt = 0; dt < 4; ++dt) o[dt] = __builtin_amdgcn_mfma_f32_32x32x16_bf16(va[S2 * 4 + dt], pf, o[dt], 0, 0, 0);
}
template <bool FIRST>
__device__ __forceinline__ void oc_add(LAS unsigned char* lds, int tid, const f32x16 (&o)[4], float f) {
#pragma unroll
    for (int dt = 0; dt < 4; ++dt)
#pragma unroll
        for (int g4 = 0; g4 < 4; ++g4) { LAS v2u* cp = (LAS v2u*)(lds + AT_OC + (dt * 4 + g4) * 4096 + tid * 8); v2u c = FIRST ? (v2u){0u, 0u} : *cp;
            c.x = pk2(bf_lo(c.x) + f * o[dt][4 * g4 + 0], bf_hi(c.x) + f * o[dt][4 * g4 + 1]);
            c.y = pk2(bf_lo(c.y) + f * o[dt][4 * g4 + 2], bf_hi(c.y) + f * o[dt][4 * g4 + 3]); *cp = c; }
}
template <int MODE>
__device__ __forceinline__ void at_step(f32x16 (&o)[4], float& m, float& l, const bf16x8 (&qf)[8], const LAS unsigned char* kb, const LAS unsigned char* vb, int j, int qb, int tq, unsigned mword, int lane) {
    f32x16 s0, s1; bf16x8 fa[8], fb[8];
#pragma unroll
    for (int i = 0; i < 16; ++i) { s0[i] = 0.f; s1[i] = 0.f; }
    {
        const int r0 = lane & 31, sw = (r0 & 15) << 4, hb = (lane >> 5) << 4; const LAS unsigned char* rp = kb + r0 * 256;
#pragma unroll
        for (int kk = 0; kk < 8; ++kk) fa[kk] = *(const LAS bf16x8*)(rp + ((32 * kk + hb) ^ sw));
#pragma unroll
        for (int kk = 0; kk < 4; ++kk) fb[kk] = *(const LAS bf16x8*)(rp + 32 * 256 + ((32 * kk + hb) ^ sw));
        __builtin_amdgcn_sched_barrier(0);
#pragma unroll
        for (int kk = 0; kk < 8; ++kk) s0 = __builtin_amdgcn_mfma_f32_32x32x16_bf16(fa[kk], qf[kk], s0, 0, 0, 0);
        __builtin_amdgcn_sched_barrier(0);
#pragma unroll
        for (int kk = 4; kk < 8; ++kk) fb[kk] = *(const LAS bf16x8*)(rp + 32 * 256 + ((32 * kk + hb) ^ sw));
#pragma unroll
        for (int kk = 0; kk < 8; ++kk) s1 = __builtin_amdgcn_mfma_f32_32x32x16_bf16(fb[kk], qf[kk], s1, 0, 0, 0);
    }
    __builtin_amdgcn_sched_barrier(0);
    bf16x8 va0[8], va1[8];
    at_vload(va0, vb, 0, lane); __builtin_amdgcn_sched_barrier(0);
    const bool edge = (MODE == MODE_SEL) ? (j == qb) : (j == qb || j == qb - 8);
    const bool blk = (MODE == MODE_SEL) ? (((mword >> j) & 1u) != 0u) : true;
    if (edge) {
        int thr = tq - (j * 64 + 4 * (lane >> 5)); asm volatile("" : "+v"(thr));
        if (MODE == MODE_SEL && !blk) thr = -1;
#pragma unroll
        for (int i = 0; i < 16; ++i) { const int c = (i & 3) + 8 * (i >> 2);
            bool v0, v1;
            if (MODE == MODE_SEL) { v0 = (c <= thr); v1 = (c + 32 <= thr); }
            else { v0 = (c <= thr) && (c + 512 > thr); v1 = (c + 32 <= thr) && (c + 32 + 512 > thr); }
            s0[i] = v0 ? s0[i] : -__builtin_inff(); s1[i] = v1 ? s1[i] : -__builtin_inff(); }
    }
    float mx = s0[0];
#pragma unroll
    for (int i = 1; i < 16; ++i) mx = fmaxf(mx, s0[i]);
#pragma unroll
    for (int i = 0; i < 16; ++i) mx = fmaxf(mx, s1[i]);
    mx = fmaxf(mx, __shfl_xor(mx, 32));
    const bool dead = (MODE == MODE_SEL) && !edge && !blk;
    mx = dead ? -__builtin_inff() : mx;
    const float mn = fmaxf(m, mx), alpha = __builtin_amdgcn_exp2f(m - mn);
    const float sub = dead ? __builtin_inff() : mn;
    const pg8::f32x2 sv = (pg8::f32x2){sub, sub}; pg8::f32x2 ps2 = (pg8::f32x2){0.f, 0.f};
#pragma unroll
    for (int i = 0; i < 16; i += 2) {
        const pg8::f32x2 a = (pg8::f32x2){s0[i], s0[i + 1]} - sv, b = (pg8::f32x2){s1[i], s1[i + 1]} - sv;
        s0[i] = __builtin_amdgcn_exp2f(a.x); s0[i + 1] = __builtin_amdgcn_exp2f(a.y); s1[i] = __builtin_amdgcn_exp2f(b.x); s1[i + 1] = __builtin_amdgcn_exp2f(b.y);
        ps2 += (pg8::f32x2){s0[i], s0[i + 1]} + (pg8::f32x2){s1[i], s1[i + 1]}; }
    const float ps = ps2.x + ps2.y;
    l = l * alpha + ps; m = mn;
    if (!__all(alpha == 1.0f)) {
#pragma unroll
        for (int dt = 0; dt < 4; ++dt)
#pragma unroll
            for (int i = 0; i < 16; ++i) o[dt][i] *= alpha;
    }
    __builtin_amdgcn_sched_barrier(0);
    at_pv_r<0>(o, va0, s0); __builtin_amdgcn_sched_barrier(0);
    at_vload(va1, vb, 1, lane); __builtin_amdgcn_sched_barrier(0);
    at_pv_r<1>(o, va0, s0); __builtin_amdgcn_sched_barrier(0);
    at_pv_r<0>(o, va1, s1); at_pv_r<1>(o, va1, s1); __builtin_amdgcn_sched_barrier(0);
}
template <int MODE>
__device__ __forceinline__ void at_branch(const bf16x8 (&qf)[8], const bf16* Kb, int pitchK, const bf16* Vb, int pitchV, int jlo, int jhi, int qb, int tq, unsigned mword, const float* gp,
                                          LAS unsigned char* lds, int tid, int lane) {
    f32x16 o[4];
#pragma unroll
    for (int dt = 0; dt < 4; ++dt)
#pragma unroll
        for (int i = 0; i < 16; ++i) o[dt][i] = 0.f;
    float m = -1e30f, l = 0.f;
    v4u krA[2], vrA[2], krB[2], vrB[2];
    at_load(krA, vrA, Kb, pitchK, Vb, pitchV, jlo, tid);
    if (jlo < jhi) at_load(krB, vrB, Kb, pitchK, Vb, pitchV, jlo + 1, tid);
    __syncthreads();
    at_store(krA, vrA, lds, 0, tid);
    __syncthreads();
    for (int j = jlo; ; j += 2) {
        if (j + 2 <= jhi) at_load(krA, vrA, Kb, pitchK, Vb, pitchV, j + 2, tid);
        at_step<MODE>(o, m, l, qf, lds + AT_K0, lds + AT_V0, j, qb, tq, mword, lane);
        if (j + 1 <= jhi) at_store(krB, vrB, lds, 1, tid);
        __syncthreads();
        if (j + 1 > jhi) break;
        if (j + 3 <= jhi) at_load(krB, vrB, Kb, pitchK, Vb, pitchV, j + 3, tid);
        at_step<MODE>(o, m, l, qf, lds + AT_K0 + AT_KB, lds + AT_V0 + AT_VB, j + 1, qb, tq, mword, lane);
        if (j + 2 <= jhi) at_store(krA, vrA, lds, 0, tid);
        __syncthreads();
        if (j + 2 > jhi) break;
    }
    l += __shfl_xor(l, 32);
    const float gate = gp[tq * 48];
    const float f = l > 0.f ? gate / l : 0.f;
    oc_add<false>(lds, tid, o, f);
}
__device__ __forceinline__ void nsa_attention(unsigned char* ws, bf16* XB, LAS unsigned char* lds, int vcu, int G) {
    const bf16* Q = (const bf16*)(ws + WS_MIX + MX_NSA_Q); const float* GT = (const float*)(ws + WS_MIX + MX_NSA_GT);
    for (int idx = vcu; idx < NB * 4 * 32; idx += G) {
        int tid = pg8::tidx(lds); asm volatile("" : "+v"(tid));
        const int lane = tid & 63, w = __builtin_amdgcn_readfirstlane(tid >> 6);
        const int L = idx & 1023, rev = idx >> 10, bg = L >> 4, qx = L & 3, qj = ((L >> 2) + (L >> 8)) & 3;
        const int q16 = qj == 0 ? qx : (qj == 1 ? 7 - qx : (qj == 2 ? 8 + qx : 15 - qx)), qb = rev ? 31 - q16 : q16, b = bg >> 2, g = bg & 3;
        const int hq = g * 4 + (w >> 1), tl = (w & 1) * 32 + (lane & 31), tq = qb * 64 + tl; const size_t row = (size_t)b * T + tq;
        bf16x8 qf[8];
#pragma unroll
        for (int kk = 0; kk < 8; ++kk) qf[kk] = *(const bf16x8*)(Q + row * 2048 + hq * 128 + 16 * kk + 8 * (lane >> 5));
        const float g_cmp = GT[row * 48 + hq];
        f32x16 ocmp[4];
#pragma unroll
        for (int dt = 0; dt < 4; ++dt)
#pragma unroll
            for (int i = 0; i < 16; ++i) ocmp[dt][i] = 0.f;
        {
            const bf16* Kb = (const bf16*)(ws + WS_MIX + MX_NSA_KCMP) + (size_t)bg * 128 * 128; const bf16* Vb = (const bf16*)(ws + WS_MIX + MX_NSA_VCMPT) + (size_t)bg * 128 * 128;
            v4u kr[2], vr[2];
            __syncthreads();
            at_load(kr, vr, Kb, 128, Vb, 128, 0, tid); at_store(kr, vr, lds, 0, tid);
            at_load(kr, vr, Kb, 128, Vb, 128, 1, tid); at_store(kr, vr, lds, 1, tid);
            __syncthreads();
            f32x16 s[4];
#pragma unroll
            for (int k4 = 0; k4 < 4; ++k4) s[k4] = at_qk(lds + AT_K0 + (k4 >> 1) * AT_KB, k4 & 1, qf, lane);
            float mx = -1e30f;
            int nthr = ((tq - 31) >> 4) - 4 * (lane >> 5); asm volatile("" : "+v"(nthr));
#pragma unroll
            for (int k4 = 0; k4 < 4; ++k4)
#pragma unroll
                for (int i = 0; i < 16; ++i) { const bool v = (32 * k4 + (i & 3) + 8 * (i >> 2) <= nthr); s[k4][i] = v ? s[k4][i] : -__builtin_inff(); mx = fmaxf(mx, s[k4][i]); }
            mx = fmaxf(mx, __shfl_xor(mx, 32));
            float ps = 0.f;
#pragma unroll
            for (int k4 = 0; k4 < 4; ++k4)
#pragma unroll
                for (int i = 0; i < 16; ++i) { s[k4][i] = __builtin_amdgcn_exp2f(s[k4][i] - mx); ps += s[k4][i]; }
            ps += __shfl_xor(ps, 32);
            const float inv = ps > 0.f ? 1.0f / ps : 0.f;
#pragma unroll
            for (int k4 = 0; k4 < 4; ++k4)
#pragma unroll
                for (int i = 0; i < 16; ++i) s[k4][i] *= inv;
            float q4[16], lastv[16];
#pragma unroll
            for (int k4 = 0; k4 < 4; ++k4)
#pragma unroll
                for (int g4 = 0; g4 < 4; ++g4) { q4[4 * k4 + g4] = (s[k4][4 * g4] + s[k4][4 * g4 + 1]) + (s[k4][4 * g4 + 2] + s[k4][4 * g4 + 3]); lastv[4 * k4 + g4] = s[k4][4 * g4 + 3]; }
            {
                const int h = lane >> 5; LAS float* ip = (LAS float*)(lds + AT_IMP) + ((w >> 1) * 64 + tl) * 32;
                float prev = 0.f;
#pragma unroll
                for (int i = 0; i < 16; ++i) { const float pl = __shfl_xor(lastv[i], 32); const float add = h ? pl : prev; prev = pl; ip[2 * i + h] = q4[i] + add; }
            }
            __builtin_amdgcn_sched_barrier(0);
            f32x16 o[4];
#pragma unroll
            for (int dt = 0; dt < 4; ++dt)
#pragma unroll
                for (int i = 0; i < 16; ++i) o[dt][i] = 0.f;
#pragma unroll
            for (int k4 = 0; k4 < 4; ++k4) { at_pv(o, lds + AT_V0 + (k4 >> 1) * AT_VB, k4 & 1, s[k4], lane); __builtin_amdgcn_sched_barrier(0); }
#pragma unroll
            for (int dt = 0; dt < 4; ++dt) ocmp[dt] = o[dt];
        }
        __syncthreads();
        {
            const int tt = tid >> 3, sub = tid & 7, cur = qb; const LAS float* ip = (const LAS float*)(lds + AT_IMP) + tt * 32;
            float sc[32];
#pragma unroll
            for (int mb = 0; mb < 32; ++mb) { float v = (ip[mb] + ip[64 * 32 + mb]) + (ip[2 * 64 * 32 + mb] + ip[3 * 64 * 32 + mb]);
                const bool forced = (mb == 0) || (mb == cur) || (mb == cur - 1);
                sc[mb] = (mb <= cur) ? (v + (forced ? 1000.f : 0.f)) : -1e30f; }
            unsigned bits = 0u;
#pragma unroll
            for (int k = 0; k < 4; ++k) { const int mb = sub * 4 + k; float mine = sc[0];
#pragma unroll
                for (int q = 1; q < 32; ++q) mine = (q == mb) ? sc[q] : mine;
                int rank = 0;
#pragma unroll
                for (int q = 0; q < 32; ++q) rank += (sc[q] > mine || (sc[q] == mine && q < mb)) ? 1 : 0;
                bits |= (rank < 16 ? 1u : 0u) << mb; }
            bits |= __shfl_xor(bits, 1); bits |= __shfl_xor(bits, 2); bits |= __shfl_xor(bits, 4);
            if (sub == 0) *(LAS unsigned*)(lds + AT_MASK + tt * 4) = bits;
        }
        __syncthreads();
        oc_add<true>(lds, tid, ocmp, g_cmp);
        const unsigned mword = *(const LAS unsigned*)(lds + AT_MASK + tl * 4);
        at_branch<MODE_SEL>(qf, (const bf16*)(ws + WS_MIX + MX_NSA_KS) + (size_t)b * T * 512 + g * 128, 512, (const bf16*)(ws + WS_MIX + MX_NSA_VST) + ((size_t)b * 512 + g * 128) * 2048, 2048,
                            0, qb, qb, tq, mword, GT + (size_t)b * T * 48 + 16 + hq, lds, tid, lane);
        at_branch<MODE_WIN>(qf, (const bf16*)(ws + WS_MIX + MX_NSA_KW) + (size_t)b * T * 512 + g * 128, 512, (const bf16*)(ws + WS_MIX + MX_NSA_VWT) + ((size_t)b * 512 + g * 128) * 2048, 2048,
                            qb > 8 ? qb - 8 : 0, qb, qb, tq, 0u, GT + (size_t)b * T * 48 + 32 + hq, lds, tid, lane);
        {
            bf16* op = XB + row * 2048 + hq * 128 + 4 * (lane >> 5);
#pragma unroll
            for (int dt = 0; dt < 4; ++dt)
#pragma unroll
                for (int g4 = 0; g4 < 4; ++g4) *(v2u*)(op + 32 * dt + 8 * g4) = *(const LAS v2u*)(lds + AT_OC + (dt * 4 + g4) * 4096 + tid * 8);
        }
    }
}
struct Args { const float* in[N_IN]; float* out; unsigned char* ws; };
constexpr int PTAB_OFF = LDSCTL_OFF + 512;
__device__ __forceinline__ unsigned long long ptab_get(LAS unsigned char* lds, int i) {
    int io = 8 * i; asm volatile("" : "+v"(io));
    const volatile LAS unsigned* p = (const volatile LAS unsigned*)(lds + PTAB_OFF + io);
    const unsigned lo = __builtin_amdgcn_readfirstlane(p[0]), hi = __builtin_amdgcn_readfirstlane(p[1]);
    return ((unsigned long long)hi << 32) | lo;
}
__device__ __forceinline__ const float* in_ptr(LAS unsigned char* lds, int i) { return (const float*)(const GAS float*)ptab_get(lds, i); }
__device__ __forceinline__ unsigned char* ws_ptr(LAS unsigned char* lds) { return (unsigned char*)(GAS unsigned char*)ptab_get(lds, N_IN + 1); }
__device__ __forceinline__ float* out_ptr(LAS unsigned char* lds) { return (float*)(GAS float*)ptab_get(lds, N_IN); }
__device__ __forceinline__ float wave_sum(float v) {
#pragma unroll
    for (int o = 1; o < 64; o <<= 1) v += __shfl_xor(v, o);
    return v;
}
enum { KIND_ID = 0, KIND_SWIGLU = 1, KIND_CONV = 2, KIND_NSA = 3 };
__device__ __forceinline__ int src_col0(int kind, int n0) {
    const int tile = n0 >> 8, rem = n0 & 255, bj = rem >> 7, i = rem & 127;
    if (kind == KIND_SWIGLU) return bj * DFF + tile * 128 + i;
    if (kind == KIND_CONV) { if (n0 < 2048) return n0; return 2048 + bj * 2048 + ((n0 - 2048) >> 8) * 128 + i; }
    if (kind == KIND_NSA) { const bool rope = tile < 10 || tile == 12 || tile == 13 || tile == 16 || tile == 17; if (!rope) return n0; return tile * 256 + (i >> 6) * 128 + (i & 63) + 64 * bj; }
    return n0;
}
struct Job { const float* src; bf16* dst; int K, Nsrc, Ndst, kind, ci, lnidx; };
constexpr int NJOBS = 32;
__device__ __forceinline__ Job get_job(LAS unsigned char* lds, int j) {
    unsigned char* ws = ws_ptr(lds); Job J; J.ci = -1; J.lnidx = -1;
    if (j < 8)       { J.src = in_ptr(lds, I_FFN_WIN) + (size_t)j * D * 2 * DFF; J.dst = (bf16*)(ws + WS_FFN_WIN + (size_t)j * SZ_FFN_WIN); J.K = D; J.Nsrc = 2 * DFF; J.Ndst = 2 * DFF; J.kind = KIND_SWIGLU; J.ci = j; J.lnidx = 3 * (j >> 1) + 2 * (j & 1) - 1; }
    else if (j < 16) { const int f = j - 8; J.src = in_ptr(lds, I_FFN_WOUT) + (size_t)f * DFF * D; J.dst = (bf16*)(ws + WS_FFN_WOUT + (size_t)f * SZ_FFN_WOUT); J.K = DFF; J.Nsrc = D; J.Ndst = D; J.kind = KIND_ID; }
    else if (j < 18) { const int f = j - 16; J.src = in_ptr(lds, I_NSA_WIN) + (size_t)f * D * NSA_NSRC; J.dst = (bf16*)(ws + WS_NSA_WIN + (size_t)f * SZ_NSA_WIN); J.K = D; J.Nsrc = NSA_NSRC; J.Ndst = NSA_NPAD; J.kind = KIND_NSA; J.ci = 8 + f; J.lnidx = 9 * f; }
    else if (j < 20) { const int f = j - 18; J.src = in_ptr(lds, I_NSA_WOUT) + (size_t)f * D * D; J.dst = (bf16*)(ws + WS_NSA_WOUT + (size_t)f * SZ_DD); J.K = D; J.Nsrc = D; J.Ndst = D; J.kind = KIND_ID; }
    else if (j == 20) { J.src = in_ptr(lds, I_CONV_WIN); J.dst = (bf16*)(ws + WS_CONV_WIN); J.K = D; J.Nsrc = CONV_N; J.Ndst = CONV_N; J.kind = KIND_CONV; J.ci = 10; J.lnidx = 3; }
    else if (j == 21) { J.src = in_ptr(lds, I_CONV_WOUT); J.dst = (bf16*)(ws + WS_CONV_WOUT); J.K = D; J.Nsrc = D; J.Ndst = D; J.kind = KIND_ID; }
    else if (j == 22) { J.src = in_ptr(lds, I_GLA_WIN); J.dst = (bf16*)(ws + WS_GLA_WIN); J.K = D; J.Nsrc = GLA_NSRC; J.Ndst = GLA_NPAD; J.kind = KIND_ID; J.ci = 11; J.lnidx = 6; }
    else if (j == 23) { J.src = in_ptr(lds, I_GLA_WOUT); J.dst = (bf16*)(ws + WS_GLA_WOUT); J.K = D; J.Nsrc = D; J.Ndst = D; J.kind = KIND_ID; }
    else if (j < 28) { const int f = j - 24; J.src = in_ptr(lds, I_NSA_CW1) + (size_t)f * 4096 * 128; J.dst = (bf16*)(ws + WS_CMP_W1T + (size_t)f * 128 * 4096 * 2); J.K = 4096; J.Nsrc = 128; J.Ndst = 128; J.kind = KIND_ID; }
    else             { const int f = j - 28; J.src = in_ptr(lds, I_NSA_CW2) + (size_t)f * 128 * 128; J.dst = (bf16*)(ws + WS_CMP_W2T + (size_t)f * 128 * 128 * 2); J.K = 128; J.Nsrc = 128; J.Ndst = 128; J.kind = KIND_ID; }
    return J;
}
__device__ __forceinline__ void transpose_item(const Job& J, const float* lg, const float* lb, float* part, LAS float* scr, int item, int lane) {
    const int nblk = J.Ndst >> 6, kb = item / nblk, nb = item - kb * nblk, k0 = 64 * kb, n0 = 64 * nb;
    const int sc = src_col0(J.kind, n0) + lane; const bool ok = sc < J.Nsrc;
    const float* wp = J.src + (size_t)k0 * J.Nsrc + (ok ? sc : 0);
    float v[64];
#pragma unroll
    for (int i = 0; i < 64; ++i) v[i] = wp[(size_t)i * J.Nsrc];
#pragma unroll
    for (int i = 0; i < 64; ++i) scr[i * 65 + lane] = ok ? v[i] : 0.f;
    LDS_WAIT(); asm volatile("" ::: "memory");
    const int c = lane & 7;
    float gk[8], bk[8];
#pragma unroll
    for (int i = 0; i < 8; ++i) { gk[i] = 1.f; bk[i] = 0.f; }
    if (J.ci >= 0 && J.lnidx >= 0) {
#pragma unroll
        for (int i = 0; i < 8; ++i) { gk[i] = lg[k0 + 8 * c + i]; bk[i] = lb[k0 + 8 * c + i]; } }
#pragma unroll
    for (int j = 0; j < 8; ++j) { const int n = (lane >> 3) + 8 * j; const LAS float* s = scr + (8 * c) * 65 + n;
        float w[8];
#pragma unroll
        for (int i = 0; i < 8; ++i) w[i] = s[i * 65];
        v4u o;
        if (J.ci >= 0) { o.x = pg8::cvt_pk_f16(w[0] * gk[0], w[1] * gk[1]); o.y = pg8::cvt_pk_f16(w[2] * gk[2], w[3] * gk[3]); o.z = pg8::cvt_pk_f16(w[4] * gk[4], w[5] * gk[5]); o.w = pg8::cvt_pk_f16(w[6] * gk[6], w[7] * gk[7]); }
        else { o.x = pk2(w[0], w[1]); o.y = pk2(w[2], w[3]); o.z = pk2(w[4], w[5]); o.w = pk2(w[6], w[7]); }
        *(v4u*)(J.dst + (size_t)(n0 + n) * J.K + k0 + 8 * c) = o;
        if (J.ci >= 0) {
            const pg8::f32x2_t u0 = pg8::unpk_f16(o.x), u1 = pg8::unpk_f16(o.y), u2 = pg8::unpk_f16(o.z), u3 = pg8::unpk_f16(o.w);
            float cs = ((u0[0] + u0[1]) + (u1[0] + u1[1])) + ((u2[0] + u2[1]) + (u3[0] + u3[1]));
            float bs = ((w[0] * bk[0] + w[1] * bk[1]) + (w[2] * bk[2] + w[3] * bk[3])) + ((w[4] * bk[4] + w[5] * bk[5]) + (w[6] * bk[6] + w[7] * bk[7]));
            cs += __shfl_xor(cs, 1); bs += __shfl_xor(bs, 1); cs += __shfl_xor(cs, 2); bs += __shfl_xor(bs, 2); cs += __shfl_xor(cs, 4); bs += __shfl_xor(bs, 4);
            if (c == 0) { part[(size_t)kb * 16384 + n0 + n] = cs; part[(size_t)(32 + kb) * 16384 + n0 + n] = bs; }
        } }
    LDS_WAIT(); asm volatile("" ::: "memory");
}
__device__ __forceinline__ void conv_phase(const bf16* BG, const bf16* U, const float* cw, bf16* out, int vcu, int NT, const LAS unsigned char* lds) {
    int gtid = pg8::tidx(lds); asm volatile("" : "+v"(gtid)); gtid += vcu * (NWAVES * 64);
    for (int idx = gtid; idx < M * 256; idx += NT) {
        const int m = idx >> 8, col = (idx & 255) * 8, t = m & (T - 1);
        const v4u u0 = *(const v4u*)(U + (size_t)m * D + col);
        v4u u1 = (v4u){0u, 0u, 0u, 0u}, u2 = (v4u){0u, 0u, 0u, 0u};
        if (t >= 1) u1 = *(const v4u*)(U + (size_t)(m - 1) * D + col);
        if (t >= 2) u2 = *(const v4u*)(U + (size_t)(m - 2) * D + col);
        const v4u bg = *(const v4u*)(BG + (size_t)m * D + col);
        const f32x4 w0a = *(const f32x4*)(cw + col), w0b = *(const f32x4*)(cw + col + 4), w1a = *(const f32x4*)(cw + D + col), w1b = *(const f32x4*)(cw + D + col + 4),
                    w2a = *(const f32x4*)(cw + 2 * D + col), w2b = *(const f32x4*)(cw + 2 * D + col + 4);
        float y[8];
#pragma unroll
        for (int p = 0; p < 4; ++p) {
            const float wl0 = p < 2 ? w0a[2 * p] : w0b[2 * p - 4], wh0 = p < 2 ? w0a[2 * p + 1] : w0b[2 * p - 3];
            const float wl1 = p < 2 ? w1a[2 * p] : w1b[2 * p - 4], wh1 = p < 2 ? w1a[2 * p + 1] : w1b[2 * p - 3];
            const float wl2 = p < 2 ? w2a[2 * p] : w2b[2 * p - 4], wh2 = p < 2 ? w2a[2 * p + 1] : w2b[2 * p - 3];
            y[2 * p]     = bf_lo(bg[p]) * (wl0 * bf_lo(u2[p]) + wl1 * bf_lo(u1[p]) + wl2 * bf_lo(u0[p]));
            y[2 * p + 1] = bf_hi(bg[p]) * (wh0 * bf_hi(u2[p]) + wh1 * bf_hi(u1[p]) + wh2 * bf_hi(u0[p]));
        }
        v4u o; o.x = pk2(y[0], y[1]); o.y = pk2(y[2], y[3]); o.z = pk2(y[4], y[5]); o.w = pk2(y[6], y[7]);
        *(v4u*)(out + (size_t)m * D + col) = o;
    }
}

__device__ const double ROPE_INV[64] = {1.0, 0.8659643233600653, 0.7498942093324559, 0.6493816315762113, 0.5623413251903491, 0.4869675251658631, 0.4216965034285822, 0.3651741272548377, 0.31622776601683794, 0.27384196342643613, 0.23713737056616552, 0.2053525026457146, 0.1778279410038923, 0.1539926526059492, 0.1333521432163324, 0.11547819846894582, 0.1, 0.08659643233600653, 0.07498942093324558, 0.06493816315762113, 0.05623413251903491, 0.04869675251658631, 0.042169650342858224, 0.03651741272548377, 0.03162277660168379, 0.027384196342643614, 0.023713737056616554, 0.02053525026457146, 0.01778279410038923, 0.01539926526059492, 0.01333521432163324, 0.011547819846894581, 0.01, 0.008659643233600654, 0.007498942093324558, 0.006493816315762113, 0.005623413251903491, 0.004869675251658631, 0.004216965034285823, 0.003651741272548377, 0.0031622776601683794, 0.0027384196342643613, 0.0023713737056616554, 0.002053525026457146, 0.0017782794100389228, 0.001539926526059492, 0.001333521432163324, 0.0011547819846894581, 0.001, 0.0008659643233600654, 0.0007498942093324559, 0.0006493816315762113, 0.0005623413251903491, 0.0004869675251658631, 0.00042169650342858224, 0.0003651741272548377, 0.00031622776601683794, 0.0002738419634264361, 0.00023713737056616554, 0.0002053525026457146, 0.00017782794100389227, 0.0001539926526059492, 0.0001333521432163324, 0.00011547819846894582};
#ifndef RESID_WGM
#define RESID_WGM 4
#endif
__global__ void __launch_bounds__(NWAVES * 64, 2) mk_fwd(Args args) {
    extern __shared__ __attribute__((aligned(16))) unsigned char lds_raw[];
    LAS unsigned char* lds = (LAS unsigned char*)lds_raw;
    volatile LAS unsigned* MISC = (volatile LAS unsigned*)(lds + MISC_OFF);
    const int tid = threadIdx.x, lane = tid & 63, wave = __builtin_amdgcn_readfirstlane(tid >> 6);
    const int G = gridDim.x; const int bx = blockIdx.x; const int vcu = (G % 8 == 0) ? (bx % 8) * (G / 8) + bx / 8 : bx;
    const int gw = vcu * NWAVES + wave, NGW = G * NWAVES, gtid = vcu * (NWAVES * 64) + tid, NT = G * NWAVES * 64;
    for (int u = tid; u < (LDS_BYTES - LDSCTL_OFF) / 4; u += NWAVES * 64) ((LAS unsigned*)(lds + LDSCTL_OFF))[u] = 0u;
    __syncthreads();
    if (tid < 2 * (N_IN + 2)) ((LAS unsigned*)(lds + PTAB_OFF))[tid] = ((const unsigned*)&args)[tid];
    if (lane == 0) ((LAS int*)(lds + pg8::WIDTAB_BYTE))[pg8::hw_wave_slot()] = wave;
    __syncthreads();
    if (pg8::wave_idx(lds) != wave) __builtin_trap();
    unsigned* ctl = (unsigned*)(ws_ptr(lds) + WS_CTL);
    XcdBarrier bar = xcd_barrier_post(ctl + CW_BAR, MISC + 8);


    {
        unsigned char* ws = ws_ptr(lds); bf16* XB = (bf16*)(ws + WS_XB);
        LAS float* scr = (LAS float*)(lds + RING_OFF + wave * 16896);
        int g = gw;
        for (int j = 0; j < NJOBS; ++j) {
            const Job J = get_job(lds, j); const int items = (J.K >> 6) * (J.Ndst >> 6);
            const float* lg = in_ptr(lds, I_LNG) + (size_t)(J.lnidx > 0 ? J.lnidx : 0) * D; const float* lb = in_ptr(lds, I_LNB) + (size_t)(J.lnidx > 0 ? J.lnidx : 0) * D;
            float* part = (float*)(ws + WS_PART) + (size_t)(J.ci > 0 ? J.ci : 0) * (2 * 32 * 16384);
            while (g < items) { transpose_item(J, lg, lb, part, scr, g, lane); g += NGW; }
            g -= items;
        }
        {
            const int* pos = (const int*)in_ptr(lds, I_POS); float* cosT = (float*)(ws + WS_COS); float* sinT = (float*)(ws + WS_SIN);
            for (int idx = gtid; idx < M * 64; idx += NT) { const int m = idx >> 6, dd = idx & 63; const double rev = (double)pos[m] * ROPE_INV[dd] * 0.15915494309189535; const float fr = (float)(rev - __builtin_rint(rev));
                cosT[idx] = __builtin_amdgcn_cosf(fr); sinT[idx] = __builtin_amdgcn_sinf(fr); }
        }
        for (int i = gtid; i < M; i += NT) *(pg8::f32x2*)((float*)(ws + WS_RS) + 2 * (size_t)i) = (pg8::f32x2){0.f, 1.f};
        if (gtid < 2048) { ((float*)(ws + WS_MISC + 8192))[gtid] = 1.f; ((float*)(ws + WS_MISC + 8192 + 8192))[gtid] = 0.f; }
        if (gw < 512) {
            const int f = gw >> 7, j = gw & 127; const float* cp = in_ptr(lds, I_NSA_CPOS) + (size_t)f * 4096; const float* w1 = in_ptr(lds, I_NSA_CW1) + (size_t)f * 4096 * 128; float sacc = 0.f;
            for (int i = 0; i < 64; ++i) { const int k = lane + 64 * i; sacc += cp[k] * w1[(size_t)k * 128 + j]; }
            sacc = wave_sum(sacc); if (lane == 0) ((float*)(ws + WS_MISC))[f * 128 + j] = sacc;
        }
        const float* x = in_ptr(lds, I_X);
        for (int idx = gtid; idx < M * (D / 8); idx += NT) { const f32x4 a = *(const f32x4*)(x + (size_t)idx * 8), b = *(const f32x4*)(x + (size_t)idx * 8 + 4);
            v4u o; o.x = pg8::cvt_pk_f16(a.x, a.y); o.y = pg8::cvt_pk_f16(a.z, a.w); o.z = pg8::cvt_pk_f16(b.x, b.y); o.w = pg8::cvt_pk_f16(b.z, b.w); *(v4u*)(XB + (size_t)idx * 8) = o; }
    }
    xcd_barrier(bar);
    {
        unsigned char* ws = ws_ptr(lds); const float* part = (const float*)(ws + WS_PART); float* csbv = (float*)(ws + WS_CSBV);
        for (int idx = gtid; idx < 12 * 2 * 16384; idx += NT) { const int ci = idx >> 15, which = (idx >> 14) & 1, n = idx & 16383;
            const float* p = part + (size_t)ci * (2 * 32 * 16384) + (size_t)which * 32 * 16384 + n; float a = 0.f;
#pragma unroll 8
            for (int kb = 0; kb < 32; ++kb) a += p[(size_t)kb * 16384];
            csbv[(size_t)(which * 12 + ci) * 16384 + n] = a; }
    }
    xcd_barrier(bar);

    for (int s = 0; s < 3 * DEPTH; ++s) {
        const int layer = s / 3, which = s - 3 * layer, kind = layer % 3, mj = layer / 3;
        unsigned char* ws = ws_ptr(lds); bf16* XB = (bf16*)(ws + WS_XB); float* XF = out_ptr(lds); bf16* HB = (bf16*)(ws + WS_MIX);
        const float* xin = (s == 0) ? in_ptr(lds, I_X) : (const float*)XF;
        bf16* A2 = (bf16*)(ws + WS_A2);
        float* pscur = (float*)(ws + WS_PS);
        const int ci = (which != 1) ? layer * 2 + (which >> 1) : (kind == 0 ? 8 + mj : (kind == 1 ? 10 : 11));
        const float* fcs = (const float*)(ws + WS_CSBV) + (size_t)ci * 16384; const float* fbv = (const float*)(ws + WS_CSBV) + (size_t)(12 + ci) * 16384;
#define FIX pg8::LnFix{fcs, fbv, (const float*)(ws + WS_RS), lds + RING_OFF + 131072}
        const bf16* rA; const bf16* rW; int rK; float rscale;
        if (which != 1) {
            const int f = layer * 2 + (which >> 1);
            {
                pg8::Gemm g{XB, (const bf16*)(ws + WS_FFN_WIN + (size_t)f * SZ_FFN_WIN), M, 2 * DFF, D}; pg8::StaticOrder S; S.init(M, 2 * DFF, G, bx);
                pg8::EpiSwiglu E{HB, DFF, FIX};
                pg8::gemm_phase<pg8::EpiSwiglu, pg8::StaticOrder, PG8_ALIGN, PG8_SP2, true>(lds + RING_OFF, g, S, E);
            }
            xcd_barrier(bar);
            rA = HB; rW = (const bf16*)(ws + WS_FFN_WOUT + (size_t)f * SZ_FFN_WOUT); rK = DFF; rscale = 0.5f;
        } else if (kind == 1) {
            {
                pg8::Gemm g{XB, (const bf16*)(ws + WS_CONV_WIN), M, CONV_N, D}; pg8::StaticOrder S; S.init(M, CONV_N, G, bx);
                pg8::EpiConvIn E{(bf16*)(ws + WS_MIX + MX_CONV_BG), (bf16*)(ws + WS_MIX + MX_CONV_U), FIX};
                pg8::gemm_phase<pg8::EpiConvIn, pg8::StaticOrder, PG8_ALIGN, PG8_SP2, true>(lds + RING_OFF, g, S, E);
            }
            xcd_barrier(bar);
            conv_phase((const bf16*)(ws + WS_MIX + MX_CONV_BG), (const bf16*)(ws + WS_MIX + MX_CONV_U), in_ptr(lds, I_CONV_W) + (size_t)mj * 3 * D, A2, vcu, NT, lds);
            xcd_barrier(bar);
            rA = A2; rW = (const bf16*)(ws + WS_CONV_WOUT); rK = D; rscale = 1.0f;
        } else if (kind == 2) {
            {
                pg8::Gemm g{XB, (const bf16*)(ws + WS_GLA_WIN), M, GLA_NPAD, D}; pg8::StaticOrder S; S.init(M, GLA_NPAD, G, bx);
                pg8::EpiGlaIn E{ws + WS_MIX, FIX};
                pg8::gemm_phase<pg8::EpiGlaIn, pg8::StaticOrder, PG8_ALIGN, PG8_SP2, true>(lds + RING_OFF, g, S, E);
            }
            xcd_barrier(bar);
            gla_prep(ws, in_ptr(lds, I_GLA_WA2) + (size_t)mj * 16 * 1024, in_ptr(lds, I_GLA_BA) + (size_t)mj * 1024, lds, vcu, G);
            xcd_barrier(bar);
            gla_scan(ws, lds, vcu, G);
            xcd_barrier(bar);
            gla_out(ws, in_ptr(lds, I_GLA_NG) + (size_t)mj * 512, A2, vcu, NT, lds);
            xcd_barrier(bar);
            rA = A2; rW = (const bf16*)(ws + WS_GLA_WOUT); rK = D; rscale = 1.0f;
        } else {
            {
                pg8::Gemm g{XB, (const bf16*)(ws + WS_NSA_WIN + (size_t)mj * SZ_NSA_WIN), M, NSA_NPAD, D}; pg8::StaticOrder S; S.init(M, NSA_NPAD, G, bx);
                pg8::EpiNsaIn E{ws + WS_MIX, (const float*)(ws + WS_COS), (const float*)(ws + WS_SIN), in_ptr(lds, I_NSA_GB) + (size_t)mj * 48, NSA_QSCALE, FIX};
                pg8::gemm_phase<pg8::EpiNsaIn, pg8::StaticOrder, PG8_ALIGN, PG8_SP2, true>(lds + RING_OFF, g, S, E);
            }
            xcd_barrier(bar);
            nsa_compress(ws, mj, lds, vcu, G);
            xcd_barrier(bar);
            nsa_attention(ws, A2, lds, vcu, G);
            xcd_barrier(bar);
            rA = A2; rW = (const bf16*)(ws + WS_NSA_WOUT + (size_t)mj * SZ_DD); rK = D; rscale = 1.0f;
        }
        {
            pg8::Gemm g{rA, rW, M, D, rK}; pg8::StaticOrder S; S.init(M, D, G, bx, RESID_WGM);
            const int lnp = s > 0 ? s - 1 : 0;
            const float* rg = s > 0 ? in_ptr(lds, I_LNG) + (size_t)lnp * D : (const float*)(ws + WS_MISC + 8192);
            const float* rb = s > 0 ? in_ptr(lds, I_LNB) + (size_t)lnp * D : (const float*)(ws + WS_MISC + 8192 + 8192);
            pg8::EpiResid E{(float*)nullptr, XB, pscur, rscale, rg, rb, (const float*)(ws + WS_RS), lds + RING_OFF + 131072};
            pg8::gemm_phase<pg8::EpiResid, pg8::StaticOrder, PG8_ALIGN, PG8_SP2>(lds + RING_OFF, g, S, E);
        }
        xcd_barrier(bar);
        {
            const float* part = (const float*)(ws + WS_PS); float* rsw = (float*)(ws + WS_RS);
            int t2 = pg8::tidx(lds); asm volatile("" : "+v"(t2));
            for (int i = vcu * 512 + t2; i < M * 2; i += NT) { const int row = i >> 1, half = i & 1; const f32x4* p = (const f32x4*)(part + ((size_t)row * 64 + half * 32));
                float sm = 0.f, sq = 0.f;
#pragma unroll
                for (int k = 0; k < 8; ++k) { const f32x4 v = p[k]; sm += v[0] + v[2]; sq += v[1] + v[3]; }
                sm += __shfl_xor(sm, 1); sq += __shfl_xor(sq, 1);
                const float mean = sm * (1.f / 2048.f), var = sq * (1.f / 2048.f) - mean * mean;
                if (half == 0) *(pg8::f32x2*)(rsw + 2 * (size_t)row) = (pg8::f32x2){mean, 1.f / sqrtf(var + LN_EPS)}; }
            xcd_barrier(bar);
        }
        if (s == 3 * DEPTH - 1) {
            const float* rsf = (const float*)(ws + WS_RS); const float* gf = in_ptr(lds, I_LNG) + (size_t)s * D; const float* bfp = in_ptr(lds, I_LNB) + (size_t)s * D;
            int t3 = pg8::tidx(lds); asm volatile("" : "+v"(t3));
            for (int i = vcu * 512 + t3; i < M * (D / 8); i += NT) { const int row = i >> 8, col = (i & 255) * 8;
                const v4u zw = *(const v4u*)(XB + (size_t)row * D + col); const pg8::f32x2 st = *(const pg8::f32x2*)(rsf + 2 * (size_t)row);
                const pg8::f32x2_t h0 = pg8::unpk_f16(zw.x), h1 = pg8::unpk_f16(zw.y), h2 = pg8::unpk_f16(zw.z), h3 = pg8::unpk_f16(zw.w);
                const f32x4 x0 = (f32x4){h0[0], h0[1], h1[0], h1[1]}, x1 = (f32x4){h2[0], h2[1], h3[0], h3[1]};
                const f32x4 g0 = *(const f32x4*)(gf + col), g1 = *(const f32x4*)(gf + col + 4), b0 = *(const f32x4*)(bfp + col), b1 = *(const f32x4*)(bfp + col + 4);
                *(f32x4*)(XF + (size_t)row * D + col) = (x0 - st.x) * st.y * g0 + b0; *(f32x4*)(XF + (size_t)row * D + col + 4) = (x1 - st.x) * st.y * g1 + b1; }
        }
    }
}

extern "C" void kernel_launch(void* const* d_in, const int* in_sizes, int n_in, void* d_out, int out_size, void* d_ws, size_t ws_size, hipStream_t stream) {
    static int grid = 0;
    if (grid == 0) {
        if (n_in != N_IN || in_sizes[0] != M * D || out_size != M * D || ws_size < WS_END) { fprintf(stderr, "kernel_launch: unexpected shapes (n_in %d, in0 %d, out %d, ws %zu need %zu)\n", n_in, n_in > 0 ? in_sizes[0] : -1, out_size, ws_size, (size_t)WS_END); grid = -1; return; }
        int dev = 0, cus = 0, per_cu = 0;
        if (hipGetDevice(&dev) != hipSuccess || hipDeviceGetAttribute(&cus, hipDeviceAttributeMultiprocessorCount, dev) != hipSuccess) { grid = -1; return; }
        if (hipFuncSetAttribute((const void*)mk_fwd, hipFuncAttributeMaxDynamicSharedMemorySize, LDS_BYTES) != hipSuccess) { fprintf(stderr, "kernel_launch: hipFuncSetAttribute failed\n"); grid = -1; return; }
        if (hipOccupancyMaxActiveBlocksPerMultiprocessor(&per_cu, (const void*)mk_fwd, NWAVES * 64, LDS_BYTES) != hipSuccess || per_cu < 1) { fprintf(stderr, "kernel_launch: occupancy query says %d\n", per_cu); }
        (void)hipGetLastError();
        grid = cus;
    }
    if (grid < 0) return;
    if (hipMemsetAsync((char*)d_ws + WS_CTL, 0, CTL_ZERO_BYTES, stream) != hipSuccess) return;
    Args a{};
    for (int i = 0; i < N_IN; ++i) a.in[i] = (const float*)d_in[i];
    a.out = (float*)d_out; a.ws = (unsigned char*)d_ws;
    hipLaunchKernelGGL(mk_fwd, dim3(grid), dim3(NWAVES * 64), LDS_BYTES, stream, a);
}
```
